# Optimizing an MI355X kernel written in HIP

```python
import jax, jax.numpy as jnp
from jax import lax
import numpy as np

D_MODEL = 1024
BATCH = 1
SEQ = 16384
DEPTH = 4

N_MEM = 256
HEAD_DIM = 64
FOX_HEADS = 8
RET_HEADS = 4
MEM_HEADS = 4
FOX_W = FOX_HEADS * HEAD_DIM
RET_W = RET_HEADS * HEAD_DIM
MEM_W = MEM_HEADS * HEAD_DIM
D_MIX = FOX_W + RET_W + MEM_W
Q_BLOCK = 128
RET_CHUNK = 128
ROPE_BASE = 10000.0
EPS = 1e-6
SPLIT_SIZES = [FOX_W, FOX_W, FOX_W, FOX_W, FOX_HEADS, RET_W, RET_W, RET_W, RET_W, MEM_W, MEM_W]
D_IN = sum(SPLIT_SIZES)
SPLIT_OFFSETS = [int(o) for o in np.cumsum(SPLIT_SIZES)[:-1]]

kernel_name = "hybrid_fox_retnet_memxattn_trunk"


def rmsnorm(x, g):
    xf = x.astype(jnp.float32)
    y = xf * lax.rsqrt(jnp.mean(xf * xf, axis=-1, keepdims=True) + EPS) * g.astype(jnp.float32)
    return y.astype(x.dtype)


def rotary(x, pos):
    d = x.shape[-1]
    half = d // 2
    freqs = ROPE_BASE ** (-jnp.arange(half, dtype=jnp.float32) / half)
    ang = pos[:, None] * freqs[None, :]
    cos, sin = jnp.cos(ang), jnp.sin(ang)
    xf = x.astype(jnp.float32)
    x1, x2 = xf[..., :half], xf[..., half:]
    return jnp.concatenate([x1 * cos - x2 * sin, x1 * sin + x2 * cos], axis=-1).astype(x.dtype)


def forgetting_attention(q, k, v, f_logit, b_f):
    B, H, S, d = q.shape
    log_f = jax.nn.log_sigmoid(f_logit.astype(jnp.float32) + b_f.astype(jnp.float32))
    c = jnp.cumsum(log_f, axis=1).transpose(0, 2, 1)
    nb = S // Q_BLOCK
    qb = q.reshape(B, H, nb, Q_BLOCK, d).transpose(2, 0, 1, 3, 4)
    cb = c.reshape(B, H, nb, Q_BLOCK).transpose(2, 0, 1, 3)
    posb = jnp.arange(S, dtype=jnp.int32).reshape(nb, Q_BLOCK)
    kpos = jnp.arange(S, dtype=jnp.int32)
    scale = d ** -0.5

    def block(args):
        qi, ci, pi = args
        s = jnp.einsum('bhqd,bhkd->bhqk', qi, k).astype(jnp.float32) * scale
        s = s + ci[..., None] - c[:, :, None, :]
        s = jnp.where(kpos[None, :] <= pi[:, None], s, -jnp.inf)
        p = jax.nn.softmax(s, axis=-1)
        return jnp.einsum('bhqk,bhkd->bhqd', p.astype(v.dtype), v)

    o = lax.map(block, (qb, cb, posb))
    return o.transpose(1, 2, 0, 3, 4).reshape(B, H, S, d)


def retention(q, k, v):
    B, H, S, d = q.shape
    C = RET_CHUNK
    N = S // C
    pos = jnp.arange(S, dtype=jnp.float32)
    q = rotary(q, pos)
    k = rotary(k, pos) * (d ** -0.5)
    log_gamma = jnp.log(1.0 - 2.0 ** (-5.0 - jnp.arange(H, dtype=jnp.float32)))
    idx = jnp.arange(C, dtype=jnp.float32)
    diff = idx[:, None] - idx[None, :]
    decay_intra = jnp.where(diff >= 0, jnp.exp(log_gamma[:, None, None] * jnp.maximum(diff, 0.0)), 0.0)
    zeta = jnp.exp(log_gamma[:, None] * (C - 1 - idx)[None, :])
    xi = jnp.exp(log_gamma[:, None] * (idx + 1)[None, :])
    decay_chunk = jnp.exp(log_gamma * C)[None, :, None, None]

    qc = q.reshape(B, H, N, C, d)
    kc = k.reshape(B, H, N, C, d)
    vc = v.reshape(B, H, N, C, d)
    a = jnp.einsum('bhncd,bhnmd->bhncm', qc, kc) * decay_intra[None, :, None]
    o_intra = jnp.einsum('bhncm,bhnme->bhnce', a, vc)
    kv = jnp.einsum('bhnmd,bhnme->bhnde', kc * zeta[None, :, None, :, None], vc)
    kv_seq = jnp.moveaxis(kv, 2, 0)

    def step(R, kv_i):
        return decay_chunk * R + kv_i, R

    _, R_prev = lax.scan(step, jnp.zeros_like(kv_seq[0]), kv_seq)
    R_prev = jnp.moveaxis(R_prev, 0, 2)
    o_cross = jnp.einsum('bhncd,bhnde->bhnce', qc * xi[None, :, None, :, None], R_prev)
    o = (o_intra + o_cross).reshape(B, H, S, d)
    of = o.astype(jnp.float32)
    of = of * lax.rsqrt(jnp.mean(of * of, axis=-1, keepdims=True) + EPS)
    return of.astype(v.dtype)


def memory_attention(q, mem, w_mkv, g_mem):
    B, H, S, d = q.shape
    mh = rmsnorm(mem, g_mem)
    kv = jnp.einsum('bmd,de->bme', mh, w_mkv)
    mk, mv = jnp.split(kv, 2, axis=-1)
    M = mem.shape[1]
    mk = mk.reshape(B, M, H, d)
    mv = mv.reshape(B, M, H, d)
    s = jnp.einsum('bhsd,bmhd->bhsm', q, mk).astype(jnp.float32) * (d ** -0.5)
    p = jax.nn.softmax(s, axis=-1)
    return jnp.einsum('bhsm,bmhd->bhsd', p.astype(mv.dtype), mv)


def hybrid_layer(x, mem, w_in, b_f, w_out, w_mkv, g_pre, g_post, g_mem):
    B, S, _ = x.shape
    h = rmsnorm(x, g_pre)
    p = jnp.einsum('bsd,de->bse', h, w_in)
    fq, fk, fv, fz, ff, rq, rk, rv, rz, mq, mz = jnp.split(p, SPLIT_OFFSETS, axis=-1)

    def heads(t, H):
        return t.reshape(B, S, H, HEAD_DIM).transpose(0, 2, 1, 3)

    def merge(t):
        return t.transpose(0, 2, 1, 3).reshape(B, S, -1)

    fox = forgetting_attention(heads(fq, FOX_HEADS), heads(fk, FOX_HEADS), heads(fv, FOX_HEADS), ff, b_f)
    ret = retention(heads(rq, RET_HEADS), heads(rk, RET_HEADS), heads(rv, RET_HEADS))
    mxa = memory_attention(heads(mq, MEM_HEADS), mem, w_mkv, g_mem)
    y = jnp.concatenate([
        merge(fox) * jax.nn.silu(fz),
        merge(ret) * jax.nn.silu(rz),
        merge(mxa) * jax.nn.silu(mz),
    ], axis=-1)
    o = jnp.einsum('bse,ed->bsd', y, w_out)
    return x + rmsnorm(o, g_post)


def setup_inputs(seed: int = 0) -> dict:
    key = jax.random.key(seed)
    ks = jax.random.split(key, 10)
    f32 = jnp.float32
    x = jax.random.normal(ks[0], (BATCH, SEQ, D_MODEL), f32)
    mem = jax.random.normal(ks[1], (BATCH, N_MEM, D_MODEL), f32)
    w_in = jax.random.normal(ks[2], (DEPTH, D_MODEL, D_IN), f32) * D_MODEL ** -0.5
    b_f = jnp.linspace(1.0, 5.0, FOX_HEADS, dtype=f32)[None, :] + 0.1 * jax.random.normal(ks[3], (DEPTH, FOX_HEADS), f32)
    w_out = jax.random.normal(ks[4], (DEPTH, D_MIX, D_MODEL), f32) * D_MIX ** -0.5
    w_mem_kv = jax.random.normal(ks[5], (DEPTH, D_MODEL, 2 * MEM_W), f32) * D_MODEL ** -0.5
    pre_norm = 1.0 + 0.02 * jax.random.normal(ks[6], (DEPTH, D_MODEL), f32)
    post_norm = 1.0 + 0.02 * jax.random.normal(ks[7], (DEPTH, D_MODEL), f32)
    mem_norm = 1.0 + 0.02 * jax.random.normal(ks[8], (DEPTH, D_MODEL), f32)
    return {"x": x, "mem": mem, "w_in": w_in, "b_f": b_f, "w_out": w_out,
            "w_mem_kv": w_mem_kv, "pre_norm": pre_norm, "post_norm": post_norm,
            "mem_norm": mem_norm}


def reference(x, mem, w_in, b_f, w_out, w_mem_kv, pre_norm, post_norm, mem_norm):
    for i in range(DEPTH):
        x = hybrid_layer(x, mem, w_in[i], b_f[i], w_out[i], w_mem_kv[i],
                         pre_norm[i], post_norm[i], mem_norm[i])
    return x
```

```cpp
#include <hip/hip_runtime.h>
#include <hip/hip_cooperative_groups.h>
#include <hip/hip_bf16.h>
#include <cstdio>
#include <cstdint>
#include <cmath>
namespace cg = cooperative_groups;
namespace pg8 {
#define PG8_LAS __attribute__((address_space(3)))
typedef unsigned short bf16_t;
typedef short bf16x8 __attribute__((ext_vector_type(8)));
typedef float f32x4 __attribute__((ext_vector_type(4)));
typedef unsigned u32x4 __attribute__((ext_vector_type(4)));
constexpr int BM = 256, BK = 64, HALF = 128, HTB = HALF * BK * 2  , STAGE_BYTES = 8 * HTB, NXCD = 8, WGM = 8;

__host__ __device__ __forceinline__ int lds_byte(int r, int c) { const int st = (r >> 4) * 2 + (c >> 5), rr = r & 15, cc = c & 31, ob = rr * 64 + cc * 2; return st * 1024 + (ob ^ (((ob >> 9) & 1) << 5)); }
__host__ __device__ __forceinline__ void stage_rc(int b, int& R, int& C) { const int st = b / 1024, sb = b % 1024, swz = sb ^ (((sb >> 9) & 1) << 5); R = (st >> 1) * 16 + swz / 64; C = (st & 1) * 32 + (swz % 64) / 2; }
__host__ __device__ __forceinline__ int perm32(int rho) { const int n = rho >> 4, i = rho & 15; return 8 * (i >> 2) + 4 * n + (i & 3); }

struct Unit { int pm, pn; };
struct Gemm { const bf16_t* A; const bf16_t* Bt; int M, N, K; };

struct StaticOrder {
    int nM, nN, nwg, G, c;
    __host__ __device__ void init(int M, int N, int G_, int c_) { nM = M / BM; nN = N / BM; nwg = nM * nN; G = G_; c = c_; }
    __host__ __device__ bool next(int i, Unit& u) const {
        const long L = (long)i * G + c; if (L >= nwg) return false;
        int wgid = (int)L; { const int q = nwg / NXCD, r = nwg % NXCD, xcd = wgid % NXCD, off = wgid / NXCD; wgid = (xcd < r ? xcd * (q + 1) : r * (q + 1) + (xcd - r) * q) + off; }
        const int nig = WGM * nN, gid = wgid / nig, fm = gid * WGM, gsz = (nM - fm) < WGM ? (nM - fm) : WGM;
        u.pm = fm + ((wgid % nig) % gsz); u.pn = (wgid % nig) / gsz; return true;
    }
    __device__ __forceinline__ void a_ready(const Unit&) const {}
    __device__ __forceinline__ void done(const Unit&) const {}
};

__device__ __forceinline__ unsigned cvt_pk_bf16(float lo, float hi) { unsigned r; asm volatile("v_cvt_pk_bf16_f32 %0, %1, %2" : "=v"(r) : "v"(lo), "v"(hi)); return r; }

template <class Epi, class Sched, bool ALIGN_EPI = false, bool SP2 = false>
__device__ __forceinline__ void gemm_phase(PG8_LAS unsigned char* lds, const Gemm g, const Sched& S, const Epi& E) {
    int tid = threadIdx.x; asm volatile("" : "+v"(tid)); const int wid = __builtin_amdgcn_readfirstlane(tid >> 6), lane = tid & 63, wr = wid >> 2, wc = wid & 3, fr = lane & 15, fq = lane >> 4;
    const int K = g.K, nt = K / BK;
    unsigned voffA[2], voffB[2];
#pragma unroll
    for (int i = 0; i < 2; ++i) { int R, C; stage_rc(tid * 16 + i * 8192, R, C); const int Rb = Epi::PERM ? ((R & ~31) + perm32(R & 31)) : R;
        voffA[i] = (unsigned)(R * K + C) * 2u; voffB[i] = (unsigned)(Rb * K + C) * 2u; }
    const size_t kstep = (size_t)(BK * 2);
    const size_t hstep = (size_t)HALF * K * 2;
    const size_t tstep = 2 * hstep;
    const unsigned ldsw = (unsigned)wid * 1024u;
    const int aoff = lds_byte(wr * 64 + fr, fq * 8), boff = lds_byte(wc * 32 + fr, fq * 8);
#define PG8_SA(b, h) (((b) * 2 + (h)) * HTB)
#define PG8_SB(b, h) ((4 + (b) * 2 + (h)) * HTB)
#define PG8_STAGE(bufoff, gbase, voff) do { _Pragma("unroll") for (int _i = 0; _i < 2; ++_i) \
        __builtin_amdgcn_global_load_lds((const unsigned*)((const char*)(gbase) + (voff)[_i]), (PG8_LAS unsigned*)(lds + (bufoff) + ldsw + _i * 8192), 16, 0, 0); } while (0)
#define PG8_LDA(dst, b, h) do { _Pragma("unroll") for (int m = 0; m < 4; ++m) _Pragma("unroll") for (int k = 0; k < 2; ++k) dst[m][k] = *(const PG8_LAS bf16x8*)(lds + PG8_SA(b, h) + aoff + m * 2048 + k * 1024); } while (0)
#define PG8_LDB(dst, b, h) do { _Pragma("unroll") for (int n = 0; n < 2; ++n) _Pragma("unroll") for (int k = 0; k < 2; ++k) dst[n][k] = *(const PG8_LAS bf16x8*)(lds + PG8_SB(b, h) + boff + n * 2048 + k * 1024); } while (0)
#define PG8_MMA(ai, bj, At, Bt) do { __builtin_amdgcn_s_setprio(1); _Pragma("unroll") for (int m = 0; m < 4; ++m) _Pragma("unroll") for (int n = 0; n < 2; ++n) _Pragma("unroll") for (int k = 0; k < 2; ++k) \
        acc[ai][bj][m][n] = __builtin_amdgcn_mfma_f32_16x16x32_bf16(Bt[n][k], At[m][k], acc[ai][bj][m][n], 0, 0, 0); __builtin_amdgcn_s_setprio(0); } while (0)
#define PG8_WAIT_V(n) asm volatile("s_waitcnt vmcnt(" #n ")" ::: "memory")
#define PG8_WAIT_L(n) asm volatile("s_waitcnt lgkmcnt(" #n ")" ::: "memory")
#define PG8_BAR __builtin_amdgcn_s_barrier()
#define PG8_SCHED __builtin_amdgcn_sched_barrier(0)
    Unit cur, nxt; int ui = 0;
    if (!S.next(0, cur)) return;
    f32x4 acc[2][2][4][2];
#pragma unroll
    for (int a = 0; a < 2; ++a)
#pragma unroll
        for (int b = 0; b < 2; ++b)
#pragma unroll
            for (int m = 0; m < 4; ++m)
#pragma unroll
                for (int n = 0; n < 2; ++n) acc[a][b][m][n] = (f32x4){0.f, 0.f, 0.f, 0.f};
    bf16x8 At[4][2], B0[2][2], B1[2][2];
    const char* cA = (const char*)g.A + (size_t)cur.pm * tstep; const char* cB = (const char*)g.Bt + (size_t)cur.pn * tstep;
    S.a_ready(cur);
    if constexpr (SP2) {
        PG8_STAGE(PG8_SB(0, 0), cB, voffB); PG8_STAGE(PG8_SB(0, 1), cB + hstep, voffB); PG8_STAGE(PG8_SA(0, 0), cA, voffA); PG8_STAGE(PG8_SA(0, 1), cA + hstep, voffA);
        if (wr == 1) PG8_BAR;
        PG8_WAIT_V(2); PG8_BAR;
        PG8_STAGE(PG8_SB(1, 0), cB + kstep, voffB); PG8_STAGE(PG8_SA(1, 0), cA + kstep, voffA); PG8_STAGE(PG8_SB(1, 1), cB + hstep + kstep, voffB);
        PG8_WAIT_V(6); PG8_BAR;
    } else {
        PG8_STAGE(PG8_SB(0, 0), cB, voffB); PG8_STAGE(PG8_SA(0, 0), cA, voffA); PG8_STAGE(PG8_SB(0, 1), cB + hstep, voffB); PG8_STAGE(PG8_SA(0, 1), cA + hstep, voffA);
        if (wr == 1) PG8_BAR;
        PG8_WAIT_V(4); PG8_BAR;
        PG8_STAGE(PG8_SB(1, 0), cB + kstep, voffB); PG8_STAGE(PG8_SA(1, 0), cA + kstep, voffA); PG8_STAGE(PG8_SB(1, 1), cB + hstep + kstep, voffB);
        PG8_WAIT_V(6); PG8_BAR;
    }
    for (;;) {
        const bool has_next = S.next(ui + 1, nxt);
        const char* nA = has_next ? (const char*)g.A + (size_t)nxt.pm * tstep : cA; const char* nB = has_next ? (const char*)g.Bt + (size_t)nxt.pn * tstep : cB;
        for (int t = 0; t < nt; t += 2) {
            const bool last = (t == nt - 2);
            const char* a1 = cA + (size_t)(t + 1) * kstep;
            const char* a2 = last ? nA : cA + (size_t)(t + 2) * kstep; const char* b2 = last ? nB : cB + (size_t)(t + 2) * kstep;
            const char* a3 = a2 + kstep; const char* b3 = b2 + kstep;
            if (last && has_next) S.a_ready(nxt);
            if constexpr (SP2) {
            PG8_LDB(B0, 0, 0); PG8_LDB(B1, 0, 1); PG8_SCHED; PG8_LDA(At, 0, 0); PG8_STAGE(PG8_SA(1, 1), a1 + hstep, voffA);
            PG8_WAIT_V(8); PG8_WAIT_L(0); PG8_BAR; PG8_MMA(0, 0, At, B0); PG8_MMA(0, 1, At, B1); PG8_BAR; PG8_SCHED;
            PG8_LDA(At, 0, 1); PG8_STAGE(PG8_SB(0, 0), b2, voffB); PG8_STAGE(PG8_SB(0, 1), b2 + hstep, voffB); PG8_STAGE(PG8_SA(0, 0), a2, voffA);
            PG8_WAIT_V(8); PG8_WAIT_L(0); PG8_BAR; PG8_MMA(1, 0, At, B0); PG8_MMA(1, 1, At, B1); PG8_BAR; PG8_SCHED;
            PG8_LDB(B0, 1, 0); PG8_LDB(B1, 1, 1); PG8_SCHED; PG8_LDA(At, 1, 0); PG8_STAGE(PG8_SA(0, 1), a2 + hstep, voffA);
            PG8_WAIT_V(8); PG8_WAIT_L(0); PG8_BAR; PG8_MMA(0, 0, At, B0); PG8_MMA(0, 1, At, B1); PG8_BAR; PG8_SCHED;
            PG8_LDA(At, 1, 1); PG8_STAGE(PG8_SB(1, 0), b3, voffB); PG8_STAGE(PG8_SB(1, 1), b3 + hstep, voffB); PG8_STAGE(PG8_SA(1, 0), a3, voffA);
            PG8_WAIT_V(8); PG8_WAIT_L(0); PG8_BAR; PG8_MMA(1, 0, At, B0); PG8_MMA(1, 1, At, B1); PG8_BAR; PG8_SCHED;
            } else {
            PG8_LDB(B0, 0, 0); PG8_SCHED; PG8_LDA(At, 0, 0); PG8_STAGE(PG8_SA(1, 1), a1 + hstep, voffA);
            PG8_WAIT_L(8); PG8_BAR; PG8_WAIT_L(0); PG8_MMA(0, 0, At, B0); PG8_BAR; PG8_SCHED;
            PG8_LDB(B1, 0, 1); PG8_STAGE(PG8_SB(0, 0), b2, voffB);
            PG8_BAR; PG8_WAIT_L(0); PG8_MMA(0, 1, At, B1); PG8_BAR;
            PG8_LDA(At, 0, 1); PG8_STAGE(PG8_SA(0, 0), a2, voffA);
            PG8_BAR; PG8_WAIT_L(0); PG8_MMA(1, 0, At, B0); PG8_BAR; PG8_SCHED;
            PG8_STAGE(PG8_SB(0, 1), b2 + hstep, voffB);
            PG8_WAIT_V(6); PG8_BAR; PG8_MMA(1, 1, At, B1); PG8_BAR;
            PG8_LDB(B0, 1, 0); PG8_SCHED; PG8_LDA(At, 1, 0); PG8_STAGE(PG8_SA(0, 1), a2 + hstep, voffA);
            PG8_WAIT_L(8); PG8_BAR; PG8_WAIT_L(0); PG8_MMA(0, 0, At, B0); PG8_BAR; PG8_SCHED;
            PG8_LDB(B1, 1, 1); PG8_STAGE(PG8_SB(1, 0), b3, voffB);
            PG8_BAR; PG8_WAIT_L(0); PG8_MMA(0, 1, At, B1); PG8_BAR;
            PG8_LDA(At, 1, 1); PG8_STAGE(PG8_SA(1, 0), a3, voffA);
            PG8_BAR; PG8_WAIT_L(0); PG8_MMA(1, 0, At, B0); PG8_BAR; PG8_SCHED;
            PG8_STAGE(PG8_SB(1, 1), b3 + hstep, voffB);
            PG8_WAIT_V(6); PG8_BAR; PG8_MMA(1, 1, At, B1); PG8_BAR;
            }
        }
        if constexpr (ALIGN_EPI) { if (wr == 0) PG8_BAR; }
        if constexpr (!Epi::AFTER_DRAIN) { E(acc, cur, wr, wc, fr, fq); S.done(cur); }
        if (!has_next) break;
#pragma unroll
        for (int a = 0; a < 2; ++a)
#pragma unroll
            for (int b = 0; b < 2; ++b)
#pragma unroll
                for (int m = 0; m < 4; ++m)
#pragma unroll
                    for (int n = 0; n < 2; ++n) acc[a][b][m][n] = (f32x4){0.f, 0.f, 0.f, 0.f};
        cur = nxt; cA = nA; cB = nB; ++ui;
        if constexpr (ALIGN_EPI) { if (wr == 1) PG8_BAR; }
    }
    PG8_WAIT_V(0);
    if constexpr (!ALIGN_EPI) { if (wr == 0) PG8_BAR; }
    PG8_BAR;
    if constexpr (Epi::AFTER_DRAIN) { E.fused(acc, cur, wr, wc, fr, fq, lds, wid, lane); S.done(cur); }
#undef PG8_SA
#undef PG8_SB
#undef PG8_STAGE
#undef PG8_LDA
#undef PG8_LDB
#undef PG8_MMA
#undef PG8_WAIT_V
#undef PG8_WAIT_L
#undef PG8_BAR
#undef PG8_SCHED
}
}
namespace fa {
using bf16=__hip_bfloat16;
using bf16x8=__attribute__((ext_vector_type(8)))short;
using s16x4=__attribute__((ext_vector_type(4)))short;
using f32x16=__attribute__((ext_vector_type(16)))float;
using f32x4=__attribute__((ext_vector_type(4)))float;
using u32x4=__attribute__((ext_vector_type(4)))unsigned;
constexpr int D=64;
constexpr int NW=8,QBLK=32,QB=QBLK*NW,KVBLK=64;
__device__ __forceinline__ int crow(int r,int hi){return (r&3)+8*(r>>2)+4*hi;}
#define SBAR() __builtin_amdgcn_sched_barrier(0)
__device__ __forceinline__ void cmask(f32x16&p0,f32x16&p1,int jb,int qrel,int hi){
  const float NEG=-INFINITY; int kb=64*jb+4*hi;
  #pragma unroll
  for(int r=0;r<16;++r){int kv=kb+(r&3)+8*(r>>2); if(kv>qrel)p0[r]=NEG; if(kv+32>qrel)p1[r]=NEG;}
}
constexpr int NSLOT=3, SLOTB=8192;
constexpr int LDS_K=0, LDS_V=NSLOT*SLOTB, LDS_WS=2*NSLOT*SLOTB, LDS_OST=LDS_WS+NW*64*4, LDS_OFF=LDS_OST+NW*4096, LDS_CL=LDS_OFF+256, LDS_BYTES=LDS_CL+65536;
constexpr float C2=0.125f*1.4426950408889634f;
__device__ __forceinline__ void glds16(const void*gsrc,unsigned lds_dst){unsigned keep;
  asm volatile("s_mov_b32 %0, m0\n\ts_mov_b32 m0, %2\n\ts_nop 0\n\tglobal_load_lds_dwordx4 %1, off\n\ts_mov_b32 m0, %0":"=&s"(keep):"v"(gsrc),"s"(lds_dst):"memory");}
__device__ __forceinline__ float max3f(float a,float b,float c){float r;asm("v_max3_f32 %0, %1, %2, %3":"=v"(r):"v"(a),"v"(b),"v"(c));return r;}
__device__ __forceinline__ float max2f(float a,float b){float r;asm("v_max_f32_e32 %0, %1, %2":"=v"(r):"v"(a),"v"(b));return r;}
__device__ __forceinline__ float fadd_s(float a,float b){float r;asm("v_add_f32_e32 %0, %1, %2":"=v"(r):"v"(a),"v"(b));return r;}
__device__ __forceinline__ float fsub_s(float a,float b){float r;asm("v_sub_f32_e32 %0, %1, %2":"=v"(r):"v"(a),"v"(b));return r;}
typedef float f32x2_t __attribute__((ext_vector_type(2))); typedef __bf16 bf16x2_t __attribute__((ext_vector_type(2)));
__device__ __forceinline__ unsigned cvtpk_s(float lo,float hi){f32x2_t v={lo,hi};bf16x2_t b=__builtin_convertvector(v,bf16x2_t);return __builtin_bit_cast(unsigned,b);}
#define WAIT_BAR(N) asm volatile("s_waitcnt vmcnt(" #N ") lgkmcnt(0)\n\ts_barrier":::"memory")
typedef __attribute__((address_space(3))) const char* lds_cptr;
typedef short v4i16_t __attribute__((ext_vector_type(4)));
__device__ __forceinline__ void qkt(f32x16&p0,f32x16&p1,lds_cptr Kslot,const bf16x8*qr,int r32,int hi){
  lds_cptr kb=Kslot+hi*1024+r32*16;
  #pragma unroll
  for(int d0=0;d0<4;++d0){
    const bf16x8 b0=*(const __attribute__((address_space(3))) bf16x8*)(kb+d0*2048);
    const bf16x8 b1=*(const __attribute__((address_space(3))) bf16x8*)(kb+d0*2048+512);
    p0=__builtin_amdgcn_mfma_f32_32x32x16_bf16(b0,qr[d0],p0,0,0,0);p1=__builtin_amdgcn_mfma_f32_32x32x16_bf16(b1,qr[d0],p1,0,0,0);}
}
__device__ __forceinline__ void kload8(bf16x8*kf,lds_cptr kp){
  kf[0]=*(const __attribute__((address_space(3))) bf16x8*)(kp);      kf[1]=*(const __attribute__((address_space(3))) bf16x8*)(kp+512);
  kf[2]=*(const __attribute__((address_space(3))) bf16x8*)(kp+2048); kf[3]=*(const __attribute__((address_space(3))) bf16x8*)(kp+2560);
  kf[4]=*(const __attribute__((address_space(3))) bf16x8*)(kp+4096); kf[5]=*(const __attribute__((address_space(3))) bf16x8*)(kp+4608);
  kf[6]=*(const __attribute__((address_space(3))) bf16x8*)(kp+6144); kf[7]=*(const __attribute__((address_space(3))) bf16x8*)(kp+6656);
}
__device__ __forceinline__ void kload2(bf16x8*kf,lds_cptr kp,int j){ kf[2*j]=*(const __attribute__((address_space(3))) bf16x8*)(kp+j*2048); kf[2*j+1]=*(const __attribute__((address_space(3))) bf16x8*)(kp+j*2048+512); }
__device__ __forceinline__ s16x4 vtr(lds_cptr p){ return __builtin_bit_cast(s16x4,__builtin_amdgcn_ds_read_tr16_b64_v4i16((__attribute__((address_space(3))) v4i16_t*)p)); }
__device__ __forceinline__ float rowmax(const f32x16&p0,const f32x16&p1){
  float a=max3f(p0[0],p0[1],p1[0]),b=max3f(p0[2],p0[3],p1[1]);a=max3f(a,p1[2],p1[3]);
  #pragma unroll
  for(int r=4;r<16;r+=4){a=max3f(a,p0[r],p0[r+1]);b=max3f(b,p0[r+2],p0[r+3]);a=max3f(a,p1[r],p1[r+1]);b=max3f(b,p1[r+2],p1[r+3]);}
  const float m=max2f(a,b);
  auto rr=__builtin_amdgcn_permlane32_swap(__float_as_uint(m),__float_as_uint(m),false,false);
  return max2f(__uint_as_float(rr[0]),__uint_as_float(rr[1]));
}
__device__ __forceinline__ void pv(f32x16*o,int vb,bf16x8 pa0,bf16x8 pa1,bf16x8 pa2,bf16x8 pa3){
  #pragma unroll
  for(int d0=0;d0<2;++d0){s16x4 lo[4],hi[4];
    #pragma unroll
    for(int ks=0;ks<4;++ks){
      asm volatile("ds_read_b64_tr_b16 %0,%1 offset:%c2":"=&v"(lo[ks]):"v"(vb),"i"(d0*4096+ks*1024):"memory");
      asm volatile("ds_read_b64_tr_b16 %0,%1 offset:%c2":"=&v"(hi[ks]):"v"(vb),"i"(d0*4096+ks*1024+512):"memory");}
    asm volatile("s_waitcnt lgkmcnt(0)":::"memory");SBAR();
    #define PK(k) (bf16x8){lo[k][0],lo[k][1],lo[k][2],lo[k][3],hi[k][0],hi[k][1],hi[k][2],hi[k][3]}
    o[d0]=__builtin_amdgcn_mfma_f32_32x32x16_bf16(pa0,PK(0),o[d0],0,0,0);
    o[d0]=__builtin_amdgcn_mfma_f32_32x32x16_bf16(pa1,PK(1),o[d0],0,0,0);
    o[d0]=__builtin_amdgcn_mfma_f32_32x32x16_bf16(pa2,PK(2),o[d0],0,0,0);
    o[d0]=__builtin_amdgcn_mfma_f32_32x32x16_bf16(pa3,PK(3),o[d0],0,0,0);
    #undef PK
  }
}
__device__ __forceinline__ float bfbits2f(unsigned short b){return __uint_as_float(((unsigned)b)<<16);}
__device__ __forceinline__ float silu_f(float z){return z/(1.f+__expf(-z));}

constexpr int SLOT_BYTES=36864;
__device__ __forceinline__ int slot_of(int part,int qb){ return part==1?63-qb:(part==2?111-qb:143-qb); }
template<int THRL,bool CAUSAL,bool BIAS,int QP,int KP,int OP,int PART>
__device__ __forceinline__ void attn_unit(int q0,int kbeg,int NT,const bf16*Qh,const bf16*__restrict__ Kh,const bf16*__restrict__ Vh,const bf16*Zh,bf16*Oh,const float*Cl,const float*Tb,const float*QNh,const float*KNh,const float*Dq,float thresh,
                                          int part,unsigned*flags,unsigned char*slot0,char*shm){
  int tid=threadIdx.x; asm volatile("":"+v"(tid)); const int lane=tid&63,r32=lane&31,hi=lane>>5; const int wid=__builtin_amdgcn_readfirstlane(tid>>6);
  const bf16*Qw=Qh+(long)(q0+wid*QBLK)*QP;
  const unsigned lds0=(unsigned)(uintptr_t)shm;
  float*wsf=(float*)(shm+LDS_WS)+wid*64;
  float cq=0.f,dq=0.f; int nfar=0;
  if constexpr(BIAS){
    float*offl=(float*)(shm+LDS_OFF); float*cll=(float*)(shm+LDS_CL); const int bq=q0>>10; int*tminp=(int*)(shm+LDS_OFF)+32;
    if(tid<16){ float tb_[16];
      _Pragma("unroll") for(int i=0;i<16;++i)tb_[i]=Tb[i];
      double s=0.0; _Pragma("unroll") for(int i=0;i<16;++i)s+=(i>=tid&&i<bq)?(double)tb_[i]:0.0; offl[tid]=(float)(-s); }
    if(thresh>0.f){
      if(tid>=64&&tid<128){ const int qb=q0>>8, l_=tid-64; float kv=(l_<=qb)?KNh[l_]:0.f; const float qn_=QNh[qb], dn_=QNh[1024+qb];
        _Pragma("unroll") for(int o_=1;o_<64;o_<<=1)kv=fmaxf(kv,__shfl_xor(kv,o_));
        if(l_==0){ offl[20]=thresh+sqrtf(qn_*kv)-dn_+1.f; *tminp=q0>>6; } }
      __syncthreads();
      const float lim=offl[20]; const int nt0=q0>>6;
      if(tid<nt0){ const int kl=64*tid+63; const float b_=Cl[q0]-(Cl[kl]+offl[kl>>10]); if(!(b_<-lim))atomicMin(tminp,tid); }
      __syncthreads();
      const int tf=__builtin_amdgcn_readfirstlane(*tminp)&~1; kbeg=64*tf; NT=(q0+256-kbeg)>>6;
    }
    if(flags){ const int NTf=(q0+256)>>6, tf=kbeg>>6, qb=q0>>8;
      if constexpr(PART==1){ const int hiT=NTf-64*part; int lo=hiT-64; lo=lo<0?0:lo; lo=lo<tf?tf:lo; if(lo>=hiT){ __syncthreads(); return; } if(hiT-lo<4)lo=hiT-4; kbeg=64*lo; NT=hiT-lo; }
      else { for(int p_=1;p_<=(qb>>4);++p_) if(tf<NTf-64*p_) nfar=p_; const int lo=(tf<NTf-64)?(NTf-64):tf; kbeg=64*lo; NT=NTf-lo; } }
    __syncthreads();
    { const float base_=Cl[q0];
      for(int i=tid;i<NT*64;i+=512){ const int k=kbeg+i; const float x_=base_-(Cl[k]+offl[k>>10]); const unsigned hb_=cvtpk_s(x_,0.f)&0xffffu; const float hf_=__uint_as_float(hb_<<16);
        ((unsigned*)cll)[i]=hb_|(cvtpk_s(x_-hf_,0.f)<<16); }
      if(tid==0)offl[24]=0.f;
      cq=Cl[q0+wid*QBLK+r32]-base_; dq=Dq[q0+wid*QBLK+r32]; }
    __syncthreads();
  }
  const bf16*ksrc=Kh+(long)(kbeg+lane)*KP+wid*8;
  const bf16*vsrc=Vh+(long)(kbeg+16*(wid&3)+(lane>>2))*KP+(wid>>2)*32+(lane&3)*8;
  const unsigned kdst=lds0+LDS_K+wid*1024, vdst=lds0+LDS_V+wid*1024;
  #define DMA_K(t,slot) glds16(ksrc+(long)(t)*KVBLK*KP,(unsigned)__builtin_amdgcn_readfirstlane(kdst+(slot)))
  #define DMA_V(t,slot) glds16(vsrc+(long)(t)*KVBLK*KP,(unsigned)__builtin_amdgcn_readfirstlane(vdst+(slot)))
  const int vb0=(int)(lds0+LDS_V)+((lane>>4)&1)*32+(lane&3)*8+(4*hi+((lane&15)>>2))*64;
  bf16x8 kf[8];
  const lds_cptr shm3=(lds_cptr)shm; const lds_cptr kp0=shm3+LDS_K+hi*1024+r32*16; const lds_cptr vp0=shm3+LDS_V+((lane>>4)&1)*32+(lane&3)*8+(4*hi+((lane&15)>>2))*64;
  const lds_cptr clz=shm3+LDS_OFF+96; const lds_cptr clp0=shm3+LDS_CL+r32*4; const unsigned ONESh=hi?0u:0x3F803F80u; unsigned cqmw=0u;
  DMA_K(0,0);DMA_V(0,0);DMA_K(1,SLOTB);
  bf16x8 qr[4];
  #pragma unroll
  for(int d0=0;d0<4;++d0)qr[d0]=*reinterpret_cast<const bf16x8*>(&Qw[(long)r32*QP+d0*16+hi*8]);
  float mhat=dq,l_reg=0.f;f32x16 o[2];o[0]=f32x16{};o[1]=f32x16{};
  const int qrel=wid*QBLK+r32;
  #define CMASK(P0,P1,t) do{ if constexpr(CAUSAL){int jb_=(t)-(NT-4); if(jb_>=0)cmask(P0,P1,jb_,qrel,hi);} }while(0)
  #define UPD_BB() do{ if constexpr(BIAS){ const float x_=cq-mhat; const unsigned hb_=cvtpk_s(x_,0.f)&0xffffu; const float hf_=__uint_as_float(hb_<<16); cqmw=hi?0u:(hb_|(cvtpk_s(x_-hf_,0.f)<<16)); } }while(0)
  #define CINIT(C0,C1,t) do{ \
    if constexpr(BIAS){   \
      const bf16x8 a0_=__builtin_bit_cast(bf16x8,(u32x4){wn0,ONESh,0u,0u}), a1_=__builtin_bit_cast(bf16x8,(u32x4){wn1,ONESh,0u,0u}), bb_=__builtin_bit_cast(bf16x8,(u32x4){ONESh,cqmw,0u,0u}); \
      C0=__builtin_amdgcn_mfma_f32_32x32x16_bf16(a0_,bb_,f32x16{},0,0,0); C1=__builtin_amdgcn_mfma_f32_32x32x16_bf16(a1_,bb_,f32x16{},0,0,0); \
      { const lds_cptr p0_=hi?clz:(clp0+((t)+1)*256); wn0=*(const __attribute__((address_space(3))) unsigned*)p0_; wn1=*(const __attribute__((address_space(3))) unsigned*)(hi?clz:(p0_+128)); } } \
    else { const float cqm_=cq-mhat; _Pragma("unroll") for(int r_=0;r_<16;++r_){C0[r_]=cqm_;C1[r_]=cqm_;} \
      asm volatile("":"+v"(C0)); asm volatile("":"+v"(C1)); } }while(0)
  UPD_BB();
  unsigned wn0=0u,wn1=0u; if constexpr(BIAS){ wn0=*(const __attribute__((address_space(3))) unsigned*)(hi?clz:clp0); wn1=*(const __attribute__((address_space(3))) unsigned*)(hi?clz:(clp0+128)); }
  bool resc=false;
  #define START(P0,P1) do{ const float rm=rowmax(P0,P1); resc=false; \
    { const float dl=rm; mhat=fadd_s(mhat,dl); \
      _Pragma("unroll") for(int r=0;r<16;++r){P0[r]=fsub_s(P0[r],dl);P1[r]=fsub_s(P1[r],dl);} } \
    _Pragma("unroll") for(int r=0;r<16;++r)P0[r]=__builtin_amdgcn_exp2f(P0[r]); }while(0)
  #define RESC() do{ if(resc){ asm volatile("s_waitcnt lgkmcnt(0)":::"memory"); \
      _Pragma("unroll") for(int d_=0;d_<2;++d_) _Pragma("unroll") for(int r=0;r<16;++r)o[d_][r]*=wsf[crow(r,hi)]; } }while(0)
  f32x16 pA0,pA1,pB0,pB1;
  int sl_prev=0,sl_cur=0,sl_next=SLOTB;
  #define ROT() do{sl_prev=sl_cur;sl_cur=sl_next;sl_next=(sl_next==(NSLOT-1)*SLOTB)?0:sl_next+SLOTB;}while(0)
  DMA_K(2,2*SLOTB);
  WAIT_BAR(3);
  CINIT(pA0,pA1,0);
  qkt(pA0,pA1,shm3+LDS_K,qr,r32,hi);asm volatile("s_nop 15\n\ts_nop 7":"+v"(pA0),"+v"(pA1));CMASK(pA0,pA1,0);
  const float skipt=(BIAS&&thresh>0.f)?-thresh:-INFINITY; bool alive=true;
  #define DECIDE(C0,C1,RM,AL) do{ AL=!(__all((RM)<skipt)!=0); \
    if(AL){ if(__any((RM)>(float)THRL)){ const float dl_=__builtin_fmaxf((RM),0.f); mhat+=dl_; UPD_BB(); _Pragma("unroll") for(int r=0;r<16;++r){C0[r]-=dl_;C1[r]-=dl_;} } \
      _Pragma("unroll") for(int r=0;r<16;++r){C0[r]=__builtin_amdgcn_exp2f(C0[r]);C1[r]=__builtin_amdgcn_exp2f(C1[r]);} } \
    else { _Pragma("unroll") for(int r=0;r<16;++r){C0[r]=0.f;C1[r]=0.f;} } }while(0)
  if constexpr(BIAS){ const float rm0=rowmax(pA0,pA1); DECIDE(pA0,pA1,rm0,alive); }
  else { START(pA0,pA1);
    _Pragma("unroll") for(int r=0;r<16;++r)pA1[r]=__builtin_amdgcn_exp2f(pA1[r]); }
  WAIT_BAR(0);
  DMA_K(3,0);DMA_V(1,SLOTB);
  ROT();
  kload8(kf,kp0+sl_cur);
  WAIT_BAR(2);
  s16x4 vlo[8],vhi[8]; u32x4 pw0,pw1,pw2,pw3;
  #define PKW(P,B) cvtpk_s(P[B],P[B+1])
  #define PAF(k) __builtin_bit_cast(bf16x8,pw##k)
  #define VFR(i) (bf16x8){vlo[i][0],vlo[i][1],vlo[i][2],vlo[i][3],vhi[i][0],vhi[i][1],vhi[i][2],vhi[i][3]}
  #define PIN(x) asm volatile("":"+v"(x))
  #define MX3(a,b,c) __builtin_fmaxf(__builtin_fmaxf((a),(b)),(c))
  #define GAPA(MF,A0,A1,A2,A3,W0,W1,PW) do{ MF; sacc+=A0; sacc+=A1; sacc+=A2; sacc+=A3; PIN(sacc); W0; W1; PIN(PW); SBAR(); }while(0)
  #define EX(v) __builtin_amdgcn_exp2f(v)
  #define GAPB(MF,X,B) do{ MF; X[B]=EX(X[B]); X[B+1]=EX(X[B+1]); X[B+2]=EX(X[B+2]); X[B+3]=EX(X[B+3]); PIN(X); SBAR(); }while(0)
  #define VRD(i) do{ vlo[i]=vtr(vp_+(((i)>>2)*4096+((i)&3)*1024)); vhi[i]=vtr(vp_+(((i)>>2)*4096+((i)&3)*1024+512)); }while(0)
  #define KRD(G,j) do{ if(G){ kload2(kf,kp0+sl_next,j); SBAR(); } }while(0)
  #define STEP(C0,C1,P0,P1,t,GK,GV,GL) do{ SBAR(); \
    CINIT(C0,C1,t); SBAR(); \
    const lds_cptr vp_=vp0+sl_prev; \
    VRD(0); SBAR(); float sacc=(P0[0]+P0[1]); \
    GAPA(C0=__builtin_amdgcn_mfma_f32_32x32x16_bf16(kf[0],qr[0],C0,0,0,0), P0[2],P0[3],P0[4],P0[5],     pw0[0]=PKW(P0,0), pw0[1]=PKW(P0,2), pw0); \
    VRD(4); SBAR(); GAPA(C1=__builtin_amdgcn_mfma_f32_32x32x16_bf16(kf[1],qr[0],C1,0,0,0), P0[6],P0[7],P0[8],P0[9],     pw0[2]=PKW(P0,4), pw0[3]=PKW(P0,6), pw0); \
    VRD(1); SBAR(); GAPA(C0=__builtin_amdgcn_mfma_f32_32x32x16_bf16(kf[2],qr[1],C0,0,0,0),   P0[10],P0[11],P0[12],P0[13], pw1[0]=PKW(P0,8), pw1[1]=PKW(P0,10), pw1); \
    VRD(5); SBAR(); GAPA(C1=__builtin_amdgcn_mfma_f32_32x32x16_bf16(kf[3],qr[1],C1,0,0,0),   P0[14],P0[15],P1[0],P1[1],   pw1[2]=PKW(P0,12),pw1[3]=PKW(P0,14), pw1); \
    VRD(2); SBAR(); GAPA(C0=__builtin_amdgcn_mfma_f32_32x32x16_bf16(kf[4],qr[2],C0,0,0,0),   P1[2],P1[3],P1[4],P1[5],     pw2[0]=PKW(P1,0), pw2[1]=PKW(P1,2), pw2); \
    VRD(6); SBAR(); GAPA(C1=__builtin_amdgcn_mfma_f32_32x32x16_bf16(kf[5],qr[2],C1,0,0,0),   P1[6],P1[7],P1[8],P1[9],     pw2[2]=PKW(P1,4), pw2[3]=PKW(P1,6), pw2); \
    VRD(3); SBAR(); GAPA(C0=__builtin_amdgcn_mfma_f32_32x32x16_bf16(kf[6],qr[3],C0,0,0,0),   P1[10],P1[11],P1[12],P1[13], pw3[0]=PKW(P1,8), pw3[1]=PKW(P1,10), pw3); \
    VRD(7); SBAR(); GAPA(C1=__builtin_amdgcn_mfma_f32_32x32x16_bf16(kf[7],qr[3],C1,0,0,0),   P1[14],P1[15],0.f,0.f,       pw3[2]=PKW(P1,12),pw3[3]=PKW(P1,14), pw3); \
    l_reg+=sacc; \
    if(GK){DMA_K((t)+3,sl_cur);} if(GV){DMA_V((t)+1,sl_next);} \
    CMASK(C0,C1,t); \
    { float a=MX3(C0[0],C0[1],C1[0]),b=MX3(C0[2],C0[3],C1[1]); a=MX3(a,C1[2],C1[3]); \
      _Pragma("unroll") for(int r=4;r<16;r+=4){a=MX3(a,C0[r],C0[r+1]);b=MX3(b,C0[r+2],C0[r+3]);a=MX3(a,C1[r],C1[r+1]);b=MX3(b,C1[r+2],C1[r+3]);} \
      float rm=__builtin_fmaxf(a,b); { auto rr=__builtin_amdgcn_permlane32_swap(__float_as_uint(rm),__float_as_uint(rm),false,false); rm=__builtin_fmaxf(__uint_as_float(rr[0]),__uint_as_float(rr[1])); } \
      resc=false; \
      if(__builtin_expect(__any(rm>(float)THRL),0)){ const float dl=__builtin_fmaxf(rm,0.f); mhat+=dl; UPD_BB(); \
        _Pragma("unroll") for(int r=0;r<16;++r){C0[r]-=dl;C1[r]-=dl;} \
        const float f=__builtin_amdgcn_exp2f(-dl); l_reg*=f; if(hi==0)wsf[r32]=f; resc=true; } } \
    SBAR(); \
    GAPB(o[0]=__builtin_amdgcn_mfma_f32_32x32x16_bf16(PAF(0),VFR(0),o[0],0,0,0), C0,0); \
    GAPB(o[1]=__builtin_amdgcn_mfma_f32_32x32x16_bf16(PAF(0),VFR(4),o[1],0,0,0), C0,4); \
    KRD(GL,0); GAPB(o[0]=__builtin_amdgcn_mfma_f32_32x32x16_bf16(PAF(1),VFR(1),o[0],0,0,0), C0,8); \
    KRD(GL,1); GAPB(o[1]=__builtin_amdgcn_mfma_f32_32x32x16_bf16(PAF(1),VFR(5),o[1],0,0,0), C0,12); \
    KRD(GL,2); GAPB(o[0]=__builtin_amdgcn_mfma_f32_32x32x16_bf16(PAF(2),VFR(2),o[0],0,0,0), C1,0); \
    KRD(GL,3); GAPB(o[1]=__builtin_amdgcn_mfma_f32_32x32x16_bf16(PAF(2),VFR(6),o[1],0,0,0), C1,4); \
    GAPB(o[0]=__builtin_amdgcn_mfma_f32_32x32x16_bf16(PAF(3),VFR(3),o[0],0,0,0), C1,8); \
    GAPB(o[1]=__builtin_amdgcn_mfma_f32_32x32x16_bf16(PAF(3),VFR(7),o[1],0,0,0), C1,12); \
    }while(0)
  int t=1;
  #undef CMASK
  #define CMASK(P0,P1,t) do{}while(0)
  if constexpr(BIAS){
    #define LIGHT(C0,C1,t,AL) do{ SBAR(); CINIT(C0,C1,t); SBAR(); \
      C0=__builtin_amdgcn_mfma_f32_32x32x16_bf16(kf[0],qr[0],C0,0,0,0); C1=__builtin_amdgcn_mfma_f32_32x32x16_bf16(kf[1],qr[0],C1,0,0,0); \
      C0=__builtin_amdgcn_mfma_f32_32x32x16_bf16(kf[2],qr[1],C0,0,0,0); C1=__builtin_amdgcn_mfma_f32_32x32x16_bf16(kf[3],qr[1],C1,0,0,0); \
      C0=__builtin_amdgcn_mfma_f32_32x32x16_bf16(kf[4],qr[2],C0,0,0,0); C1=__builtin_amdgcn_mfma_f32_32x32x16_bf16(kf[5],qr[2],C1,0,0,0); \
      C0=__builtin_amdgcn_mfma_f32_32x32x16_bf16(kf[6],qr[3],C0,0,0,0); C1=__builtin_amdgcn_mfma_f32_32x32x16_bf16(kf[7],qr[3],C1,0,0,0); SBAR(); \
      DMA_K((t)+3,sl_cur); DMA_V((t)+1,sl_next); \
      { float a=MX3(C0[0],C0[1],C1[0]),b=MX3(C0[2],C0[3],C1[1]); a=MX3(a,C1[2],C1[3]); \
        _Pragma("unroll") for(int r=4;r<16;r+=4){a=MX3(a,C0[r],C0[r+1]);b=MX3(b,C0[r+2],C0[r+3]);a=MX3(a,C1[r],C1[r+1]);b=MX3(b,C1[r+2],C1[r+3]);} \
        float rm=__builtin_fmaxf(a,b); { auto rr=__builtin_amdgcn_permlane32_swap(__float_as_uint(rm),__float_as_uint(rm),false,false); rm=__builtin_fmaxf(__uint_as_float(rr[0]),__uint_as_float(rr[1])); } \
        DECIDE(C0,C1,rm,AL); } \
      kload8(kf,kp0+sl_next); }while(0)
    while(!alive&&t+6<NT){
      LIGHT(pB0,pB1,t,alive); WAIT_BAR(2); ROT(); ++t;
      if(alive){ STEP(pA0,pA1,pB0,pB1,t,true,true,true); WAIT_BAR(2); RESC(); ROT(); ++t; break; }
      LIGHT(pA0,pA1,t,alive); WAIT_BAR(2); ROT(); ++t;
    }
    #undef LIGHT
  }
  for(;t+5<NT;t+=2){
    STEP(pB0,pB1,pA0,pA1,t,true,true,true);     WAIT_BAR(2); RESC(); ROT();
    STEP(pA0,pA1,pB0,pB1,t+1,true,true,true);   WAIT_BAR(2); RESC(); ROT();
  }
  #undef CMASK
  #define CMASK(P0,P1,t) do{ if constexpr(CAUSAL){int jb_=(t)-(NT-4); if(jb_>=0)cmask(P0,P1,jb_,qrel,hi);} }while(0)
  #define ENDW(tt) do{ if((tt)+3<NT){WAIT_BAR(2);} else if((tt)+2<NT){WAIT_BAR(1);} else {WAIT_BAR(0);} }while(0)
  for(;t+1<NT;t+=2){
    STEP(pB0,pB1,pA0,pA1,t,(t+3<NT),(t+1<NT),(t+1<NT));       ENDW(t);   RESC(); ROT();
    STEP(pA0,pA1,pB0,pB1,t+1,(t+4<NT),(t+2<NT),(t+2<NT));     ENDW(t+1); RESC(); ROT();
  }
  STEP(pB0,pB1,pA0,pA1,NT-1,false,false,false); RESC();
  { float sacc=pB0[0]+pB0[1]; _Pragma("unroll") for(int r=2;r<16;++r)sacc+=pB0[r]; _Pragma("unroll") for(int r=0;r<16;++r)sacc+=pB1[r]; l_reg+=sacc;
    pw0=(u32x4){PKW(pB0,0),PKW(pB0,2),PKW(pB0,4),PKW(pB0,6)};pw1=(u32x4){PKW(pB0,8),PKW(pB0,10),PKW(pB0,12),PKW(pB0,14)};pw2=(u32x4){PKW(pB1,0),PKW(pB1,2),PKW(pB1,4),PKW(pB1,6)};pw3=(u32x4){PKW(pB1,8),PKW(pB1,10),PKW(pB1,12),PKW(pB1,14)};
    SBAR(); pv(o,vb0+sl_cur,PAF(0),PAF(1),PAF(2),PAF(3)); }
  #undef PKW
  #undef PAF
  #undef VFR
  #undef PIN
  #undef MX3
  #undef GAPA
  #undef GAPB
  #undef EX
  #undef VRD
  #undef KRD
  #undef STEP
  #undef ENDW
  #undef CINIT
  #undef UPD_BB
  #undef DECIDE
  {auto rr=__builtin_amdgcn_permlane32_swap(__float_as_uint(l_reg),__float_as_uint(l_reg),false,false);l_reg=__uint_as_float(rr[0])+__uint_as_float(rr[1]);}
  if constexpr(BIAS&&PART==0){
    for(int p_=1;p_<=nfar;++p_){ const int e_=slot_of(p_,q0>>8);
      if(tid==0){ unsigned sp_=0; while(__hip_atomic_load(&flags[e_],__ATOMIC_RELAXED,__HIP_MEMORY_SCOPE_AGENT)==0u){ __builtin_amdgcn_s_sleep(2); if(++sp_>(1u<<22))break; } }
      __syncthreads();
      __builtin_amdgcn_fence(__ATOMIC_ACQUIRE,"agent");
      const unsigned char*slot=slot0+(size_t)e_*SLOT_BYTES; const float*ml=(const float*)(slot+32768)+wid*64;
      const float mi=ml[r32],li=ml[32+r32]; const float M_=fmaxf(mhat,mi); const float fo=__builtin_amdgcn_exp2f(mhat-M_),g_=li*__builtin_amdgcn_exp2f(mi-M_);
      l_reg=l_reg*fo+g_; mhat=M_;
      u32x4 ov[4];
      #pragma unroll
      for(int j=0;j<4;++j)ov[j]=((const u32x4*)slot)[(wid*4+j)*64+lane];
      if(hi==0){wsf[r32]=fo;wsf[32+r32]=g_;} asm volatile("s_waitcnt lgkmcnt(0)":::"memory");
      #pragma unroll
      for(int d0=0;d0<2;++d0)
        #pragma unroll
        for(int r=0;r<16;++r){ const unsigned w_=ov[d0*2+(r>>3)][(r&7)>>1]; const float oi=(r&1)?__uint_as_float(w_&0xffff0000u):__uint_as_float(w_<<16);
          o[d0][r]=o[d0][r]*wsf[crow(r,hi)]+wsf[32+crow(r,hi)]*oi; }
      asm volatile("s_waitcnt lgkmcnt(0)":::"memory");
    }
  }
  if(hi==0)wsf[32+r32]=l_reg;asm volatile("s_waitcnt lgkmcnt(0)":::"memory");
  float rli[16];
  #pragma unroll
  for(int r=0;r<16;++r)rli[r]=__builtin_amdgcn_rcpf(wsf[32+crow(r,hi)]);
  if constexpr(PART==1){
    const int e_=slot_of(part,q0>>8); unsigned char*slot=slot0+(size_t)e_*SLOT_BYTES;
    #pragma unroll
    for(int j=0;j<4;++j){ const int d0=j>>1,rb=8*(j&1); u32x4 w;
      #pragma unroll
      for(int i=0;i<4;++i)w[i]=cvtpk_s(o[d0][rb+2*i]*rli[rb+2*i],o[d0][rb+2*i+1]*rli[rb+2*i+1]);
      ((u32x4*)slot)[(wid*4+j)*64+lane]=w; }
    if(hi==0){ float*ml=(float*)(slot+32768)+wid*64; ml[r32]=mhat; ml[32+r32]=l_reg; }
    asm volatile("s_waitcnt vmcnt(0) lgkmcnt(0)":::"memory");
    __syncthreads();
    if(tid==0){ __builtin_amdgcn_fence(__ATOMIC_RELEASE,"agent"); asm volatile("s_waitcnt vmcnt(0)":::"memory"); __hip_atomic_store(&flags[e_],1u,__ATOMIC_RELAXED,__HIP_MEMORY_SCOPE_AGENT); }
    asm volatile("s_waitcnt lgkmcnt(0)\n\ts_barrier":::"memory");
    return;
  }
  bf16*Ow=Oh+(long)(q0+wid*QBLK)*OP; const bf16*Zw=Zh+(long)(q0+wid*QBLK)*QP;
  { bf16*stg=(bf16*)(shm+LDS_OST)+wid*2048;
    #pragma unroll
    for(int r=0;r<16;++r){const int orow=crow(r,hi);
      #pragma unroll
      for(int d0=0;d0<2;++d0)stg[orow*64+d0*32+r32]=__float2bfloat16(o[d0][r]*rli[r]);}
    asm volatile("s_waitcnt lgkmcnt(0)":::"memory");
    #pragma unroll
    for(int i=0;i<4;++i){const int row=i*8+(lane>>3),ch=lane&7; const u32x4 v=*(const u32x4*)(stg+row*64+ch*8); const u32x4 z=*(const u32x4*)(Zw+(long)row*QP+ch*8);
      u32x4 w;
      #pragma unroll
      for(int e=0;e<4;++e){ const float a0=__uint_as_float(v[e]<<16),a1=__uint_as_float(v[e]&0xffff0000u); const float z0=__uint_as_float(z[e]<<16),z1=__uint_as_float(z[e]&0xffff0000u);
        w[e]=cvtpk_s(a0*silu_f(z0),a1*silu_f(z1)); }
      asm volatile("global_store_dwordx4 %0, %1, off sc1\n\ts_nop 1"::"v"(Ow+(long)row*OP+ch*8),"v"(w):"memory"); } }
  asm volatile("s_waitcnt lgkmcnt(0)\n\ts_barrier":::"memory");
  #undef DMA_K
  #undef DMA_V
  #undef CMASK
  #undef START
  #undef RESC
  #undef ROT
}
#undef SBAR
#undef WAIT_BAR
}
#define LAS __attribute__((address_space(3)))
typedef unsigned short u16;
typedef float f32x4g __attribute__((ext_vector_type(4)));
typedef unsigned u32x4g __attribute__((ext_vector_type(4)));
typedef unsigned u32x2g __attribute__((ext_vector_type(2)));
typedef short bf16x8g __attribute__((ext_vector_type(8)));

constexpr int S_ = 16384, DM_ = 1024, DEPTH_ = 4, NMEM = 256;
constexpr int DIN_ORIG = 3592, NIN = 3584;
constexpr int PP = NIN;
constexpr int C_FQ = 0, C_FK = 512, C_FV = 1024, C_FZ = 1536, C_RQ = 2048, C_RK = 2304, C_RV = 2560, C_RZ = 2816, C_MQ = 3072, C_MZ = 3328;
constexpr float EPS_ = 1e-6f;
constexpr float LOG2E = 1.4426950408889634f;
constexpr int NTHR = 512;
#ifndef PRUNE_THRESH
#define PRUNE_THRESH 54.0f
#endif

#ifndef FOX_SPLIT
#define FOX_SPLIT 0
#endif
constexpr size_t MiB = 1u << 20;
constexpr size_t WS_BT0 = 1 * MiB;
constexpr size_t WS_BT1 = WS_BT0 + (size_t)(NIN + 2048) * 1024 * 2;
constexpr size_t BT_STRIDE = (size_t)NIN * 1024 * 2;
constexpr size_t WS_WOT = WS_BT1 + 3 * BT_STRIDE;
constexpr size_t WS_WF = WS_WOT + 4 * (size_t)1024 * 1024 * 2;
constexpr size_t WS_ROPE = WS_WF + 4 * 8 * 1024 * 4;
constexpr size_t WS_H = WS_ROPE + (size_t)S_ * 32 * 8;
constexpr size_t WS_P = WS_H + (size_t)(S_ + 1024) * 1024 * 2;
constexpr size_t WS_MKV = WS_P + (size_t)S_ * PP * 2;
constexpr size_t WS_LF = WS_MKV + 4 * (size_t)256 * 512 * 2;
constexpr size_t WS_CL = WS_LF + (size_t)S_ * 8 * 4;
constexpr size_t WS_TB = WS_CL + (size_t)S_ * 8 * 4;
constexpr size_t WS_KVST = WS_TB + 4096;
constexpr size_t WS_QN = WS_KVST + (size_t)4 * 128 * 4096 * 4;
constexpr size_t WS_PART = WS_QN + 8192;
constexpr size_t WS_XB = WS_PART + (FOX_SPLIT ? (size_t)768 * fa::SLOT_BYTES : 0);
constexpr size_t WS_DQ = WS_XB + (size_t)S_ * 1024 * 2;
constexpr size_t WS_END = WS_DQ + (size_t)8 * S_ * 4;
static_assert(WS_END <= 256 * MiB, "workspace map must fit 256 MiB");
static_assert((size_t)S_ * 1024 * 4 <= (size_t)S_ * PP * 2, "O overlays P");

constexpr int LDS_BYTES = 152 * 1024;
static_assert(fa::LDS_BYTES <= LDS_BYTES - 64 && pg8::STAGE_BYTES <= LDS_BYTES - 64, "LDS");

__device__ __forceinline__ void st16_wt(void* ptr, u32x4g v) { asm volatile("global_store_dwordx4 %0, %1, off sc1\n\ts_nop 1" :: "v"(ptr), "v"(v) : "memory"); }
typedef float f32x2h __attribute__((ext_vector_type(2))); typedef __bf16 bf16x2h __attribute__((ext_vector_type(2)));
__device__ __forceinline__ unsigned pk2(float lo, float hi) { const f32x2h v = {lo, hi}; return __builtin_bit_cast(unsigned, __builtin_convertvector(v, bf16x2h)); }
__device__ __forceinline__ unsigned f2bf(float f) { return pk2(f, 0.f) & 0xffffu; }
__device__ __forceinline__ float bf2f(u16 b) { return __uint_as_float(((unsigned)b) << 16); }
template <int CTRL> __device__ __forceinline__ float dppf(float v) { return __builtin_bit_cast(float, __builtin_amdgcn_update_dpp(0, __builtin_bit_cast(int, v), CTRL, 0xf, 0xf, true)); }
__device__ __forceinline__ float wave_sum(float v) {
    v += dppf<0xB1>(v);
    v += dppf<0x4E>(v);
    v += dppf<0x141>(v);
    v += dppf<0x140>(v);
    const int b = __builtin_bit_cast(int, v);
    const float s0 = __builtin_bit_cast(float, __builtin_amdgcn_readlane(b, 0)), s1 = __builtin_bit_cast(float, __builtin_amdgcn_readlane(b, 16));
    const float s2 = __builtin_bit_cast(float, __builtin_amdgcn_readlane(b, 32)), s3 = __builtin_bit_cast(float, __builtin_amdgcn_readlane(b, 48));
    return (s0 + s1) + (s2 + s3);
}

struct Params {
    const float* x; const float* mem; const float* w_in; const float* b_f; const float* w_out; const float* w_mkv; const float* g_pre; const float* g_post; const float* g_mem;
    float* out; unsigned char* ws; int ph_lo, ph_hi;
};

__device__ __forceinline__ unsigned char* wsbase(const Params& p) { unsigned char* w = p.ws; asm volatile("" : "+s"(w)); return w; }

__device__ __forceinline__ int win_col(int n) {
    if (n < 2048) return n;
    if (n < 2560) { const int hd = (n - 2048) >> 6, c = (n - 2048) & 63; return 2056 + hd * 64 + (c >> 1) + 32 * (c & 1); }
    return n + 8;
}
template <bool WIN>
__device__ __forceinline__ void transpose_load(const float* W, int ldw, int k0, int n0, LAS float* scr, int tid) {
    const int nn = tid & 63, kk = tid >> 6; const int col = WIN ? win_col(n0 + nn) : (n0 + nn);
#pragma unroll
    for (int i = 0; i < 8; ++i) scr[(kk + 8 * i) * 65 + nn] = W[(size_t)(k0 + kk + 8 * i) * ldw + col];
}
__device__ __forceinline__ void transpose_store(u16* WT, int k0, int n0, const LAS float* scr, int tid) {
    const int nn = tid >> 3, c = tid & 7; const LAS float* s = scr + (8 * c) * 65 + nn;
    u32x4g o; o.x = pk2(s[0], s[65]); o.y = pk2(s[2 * 65], s[3 * 65]); o.z = pk2(s[4 * 65], s[5 * 65]); o.w = pk2(s[6 * 65], s[7 * 65]);
    *(u32x4g*)(WT + (size_t)(n0 + nn) * 1024 + k0 + 8 * c) = o;
}
struct TTile { const float* W; u16* WT; int ldw, k0, n0; bool win; };
__device__ __forceinline__ TTile ttile(const Params& p, int it) {
    constexpr int T_IN = 56 * 16, T_OUT = 16 * 16, T_MKV = 8 * 16; unsigned char* ws = wsbase(p); TTile t;
    if (it < 4 * T_IN) { const int l = it / T_IN, r = it % T_IN; t.W = p.w_in + (size_t)l * 1024 * DIN_ORIG; t.ldw = DIN_ORIG; t.WT = (u16*)(ws + (l == 0 ? WS_BT0 : WS_BT1 + (size_t)(l - 1) * BT_STRIDE)); t.n0 = (r >> 4) * 64; t.k0 = (r & 15) * 64; t.win = true; }
    else if (it < 4 * (T_IN + T_OUT)) { const int q = it - 4 * T_IN, l = q / T_OUT, r = q % T_OUT; t.W = p.w_out + (size_t)l * 1024 * 1024; t.ldw = 1024; t.WT = (u16*)(ws + WS_WOT) + (size_t)l * 1024 * 1024; t.n0 = (r >> 4) * 64; t.k0 = (r & 15) * 64; t.win = false; }
    else { const int q = it - 4 * (T_IN + T_OUT), l = q / T_MKV, r = q % T_MKV; t.W = p.w_mkv + (size_t)l * 1024 * 512; t.ldw = 512; t.WT = (u16*)(ws + WS_BT0) + (size_t)(NIN + 512 * l) * 1024; t.n0 = (r >> 4) * 64; t.k0 = (r & 15) * 64; t.win = false; }
    return t;
}

__device__ __forceinline__ void transpose_range(const Params& p, int first, int count, int idx, int nw, LAS float* scr, int tid) {
    for (int j0 = idx * 4; j0 < count; j0 += nw * 4) {
#pragma unroll
        for (int q = 0; q < 4; ++q) { if (j0 + q < count) { const TTile t = ttile(p, first + j0 + q); if (t.win) transpose_load<true>(t.W, t.ldw, t.k0, t.n0, scr + q * 4224, tid); else transpose_load<false>(t.W, t.ldw, t.k0, t.n0, scr + q * 4224, tid); } }
        __syncthreads();
#pragma unroll
        for (int q = 0; q < 4; ++q) { if (j0 + q < count) { const TTile t = ttile(p, first + j0 + q); transpose_store(t.WT, t.k0, t.n0, scr + q * 4224, tid); } }
        __syncthreads();
    }
}

template <int XIN, int XOUT, bool FG>
__device__ __forceinline__ void norm_phase(const Params& p, int L, LAS float* wfl, int tid) {
    asm volatile("" : "+v"(tid));
    constexpr bool HAS_O = XOUT != 0, HAS_H = XOUT != 2;
    unsigned char* ws = wsbase(p); const int lane = tid & 63, wid = tid >> 6;
    const float* xprev = p.x; u16* XB = (u16*)(ws + WS_XB);
    const u16* O = (const u16*)(ws + WS_P);
    u16* H = (u16*)(ws + WS_H); float* LF = (float*)(ws + WS_LF);
    if constexpr (HAS_H && FG) { const float* wf = p.w_in + (size_t)L * 1024 * DIN_ORIG + 2048;
        for (int i = tid; i < 8 * 1024; i += NTHR) { const int g = i & 7, k = i >> 3; wfl[g * 1024 + k] = wf[(size_t)k * DIN_ORIG + g]; }
        __syncthreads(); }
    f32x4g gpo[4], gpr[4];
#pragma unroll
    for (int j = 0; j < 4; ++j) { gpo[j] = HAS_O ? *((const f32x4g*)(p.g_post + (size_t)(L - 1) * 1024) + lane + 64 * j) : (f32x4g){0.f, 0.f, 0.f, 0.f};
        gpr[j] = HAS_H ? *((const f32x4g*)(p.g_pre + (size_t)L * 1024) + lane + 64 * j) : (f32x4g){0.f, 0.f, 0.f, 0.f}; }
    float bfv = 0.f; if (HAS_H && FG && lane < 8) bfv = p.b_f[L * 8 + lane];
    const int rstride = gridDim.x * 8;
    for (int row0 = blockIdx.x * 8 + wid; row0 < S_; row0 += 2 * rstride) {
        f32x4g v[2][4]; f32x4g o[2][4]; bool ok[2];
#pragma unroll
        for (int r = 0; r < 2; ++r) { const int row = row0 + r * rstride; ok[r] = row < S_; const int rw = ok[r] ? row : row0;
#pragma unroll
            for (int j = 0; j < 4; ++j) { if constexpr (XIN == 1) { const u32x2g xb = *((const u32x2g*)(XB + (size_t)rw * 1024) + lane + 64 * j);
                    v[r][j] = (f32x4g){__uint_as_float(xb.x << 16), __uint_as_float(xb.x & 0xffff0000u), __uint_as_float(xb.y << 16), __uint_as_float(xb.y & 0xffff0000u)}; }
                else v[r][j] = *((const f32x4g*)(xprev + (size_t)rw * 1024) + lane + 64 * j); }
            if constexpr (HAS_O) {
#pragma unroll
                for (int j = 0; j < 4; ++j) { const u32x2g ob = *((const u32x2g*)(O + (size_t)rw * 1024) + lane + 64 * j);
                    o[r][j] = (f32x4g){__uint_as_float(ob.x << 16), __uint_as_float(ob.x & 0xffff0000u), __uint_as_float(ob.y << 16), __uint_as_float(ob.y & 0xffff0000u)}; } } }
#pragma unroll
        for (int r = 0; r < 2; ++r) { const int row = row0 + r * rstride; if (!ok[r]) continue;
            if constexpr (HAS_O) { float s = 0.f;
#pragma unroll
                for (int j = 0; j < 4; ++j) s += (o[r][j].x * o[r][j].x + o[r][j].y * o[r][j].y) + (o[r][j].z * o[r][j].z + o[r][j].w * o[r][j].w);
                const float rs = 1.0f / sqrtf(wave_sum(s) * (1.f / 1024.f) + EPS_);
#pragma unroll
                for (int j = 0; j < 4; ++j) { v[r][j] = v[r][j] + o[r][j] * rs * gpo[j];
                    if constexpr (XOUT == 1) { u32x2g w; w.x = pk2(v[r][j].x, v[r][j].y); w.y = pk2(v[r][j].z, v[r][j].w); *((u32x2g*)(XB + (size_t)row * 1024) + lane + 64 * j) = w; }
                    else *((f32x4g*)(p.out + (size_t)row * 1024) + lane + 64 * j) = v[r][j]; } }
            if constexpr (HAS_H) {
                float s = 0.f;
#pragma unroll
                for (int j = 0; j < 4; ++j) s += (v[r][j].x * v[r][j].x + v[r][j].y * v[r][j].y) + (v[r][j].z * v[r][j].z + v[r][j].w * v[r][j].w);
                const float rs = 1.0f / sqrtf(wave_sum(s) * (1.f / 1024.f) + EPS_);
#pragma unroll
                for (int j = 0; j < 4; ++j) { v[r][j] = v[r][j] * rs * gpr[j];
                    u32x2g w; w.x = pk2(v[r][j].x, v[r][j].y); w.y = pk2(v[r][j].z, v[r][j].w);
                    *((u32x2g*)(H + (size_t)row * 1024) + lane + 64 * j) = w; }
                if constexpr (FG) {
                float mine = 0.f;
#pragma unroll
                for (int g = 0; g < 8; ++g) { float a = 0.f;
#pragma unroll
                    for (int j = 0; j < 4; ++j) { const f32x4g w = *((const LAS f32x4g*)(wfl + g * 1024) + lane + 64 * j); a += (v[r][j].x * w.x + v[r][j].y * w.y) + (v[r][j].z * w.z + v[r][j].w * w.w); }
                    a = wave_sum(a); if (lane == g) mine = a; }
                if (lane < 8) { const float z = mine + bfv; const float ls = fminf(z, 0.f) - log1pf(expf(-fabsf(z))); LF[(size_t)row * 8 + lane] = ls; }
                }
            }
        }
    }
}

__device__ __forceinline__ void fgate_mfma(const Params& p, int L, LAS unsigned char* lds, int tid) {
    asm volatile("" : "+v"(tid));
    unsigned char* ws = wsbase(p); const int lane = tid & 63, w = tid >> 6, l15 = lane & 15, lq = lane >> 4, rt = w & 3, kh = w >> 2;
    const u16* H = (const u16*)(ws + WS_H); const u16* WFB = (const u16*)(ws + WS_WF) + (size_t)L * 16 * 1024; float* LF = (float*)(ws + WS_LF);
    for (int rg = blockIdx.x; rg < S_ / 64; rg += gridDim.x) {
    const int r0 = rg * 64 + rt * 16;
    const u16* ap = H + (size_t)(r0 + l15) * 1024 + kh * 512 + 8 * lq; const u16* bp = WFB + (size_t)l15 * 1024 + kh * 512 + 8 * lq;
    pg8::f32x4 acc = {0.f, 0.f, 0.f, 0.f};
#pragma unroll
    for (int ks = 0; ks < 16; ++ks) { const bf16x8g a = *(const bf16x8g*)(ap + ks * 32), b = *(const bf16x8g*)(bp + ks * 32); acc = __builtin_amdgcn_mfma_f32_16x16x32_bf16(a, b, acc, 0, 0, 0); }
    float v[4];
#pragma unroll
    for (int j = 0; j < 4; ++j) v[j] = acc[j] + __shfl_xor(acc[j], 8);
    LAS float* xch = (LAS float*)lds;
    if (kh == 1) { *(LAS f32x4g*)(xch + (rt * 64 + lane) * 4) = (f32x4g){v[0], v[1], v[2], v[3]}; }
    __syncthreads();
    if (kh == 0) { const f32x4g o = *(const LAS f32x4g*)(xch + (rt * 64 + lane) * 4);
        if (l15 < 8) { const float bfv = p.b_f[L * 8 + l15];
#pragma unroll
            for (int j = 0; j < 4; ++j) { const float z = v[j] + o[j] + bfv; LF[(size_t)(r0 + lq * 4 + j) * 8 + l15] = fminf(z, 0.f) - log1pf(expf(-fabsf(z))); } } }
    __syncthreads();
    }
}

__device__ __forceinline__ void cumsum_item(const Params& p, int j, int tid) {
    asm volatile("" : "+v"(tid));
    unsigned char* ws = wsbase(p); const float* LF = (const float*)(ws + WS_LF); float* CL = (float*)(ws + WS_CL); float* TB = (float*)(ws + WS_TB);
    const int lane = tid & 63, h = tid >> 6; const int r0 = j * 1024 + lane * 16;
    float v[16]; float run = 0.f;
#pragma unroll
    for (int i = 0; i < 16; ++i) { run += LF[(size_t)(r0 + i) * 8 + h]; v[i] = run; }
    float inc = run;
#pragma unroll
    for (int o = 1; o < 64; o <<= 1) { const float t = __shfl_up(inc, o); if (lane >= o) inc += t; }
    const float excl = inc - run;
#pragma unroll
    for (int i = 0; i < 16; ++i) CL[(size_t)h * S_ + r0 + i] = (excl + v[i]) * LOG2E;
    if (lane == 63) TB[h * 16 + j] = inc * LOG2E;
}

__device__ __forceinline__ void qknorm_item(const Params& p, int h, int qb, LAS unsigned char* lds, int tid) {
    asm volatile("" : "+v"(tid));
    unsigned char* ws = wsbase(p); const u16* P = (const u16*)(ws + WS_P); float* QN = (float*)(ws + WS_QN);
    const int row = qb * 256 + (tid >> 1), half = tid & 1;
    const u16* qp = P + (size_t)row * PP + C_FQ + h * 64 + half * 32; const u16* kp = P + (size_t)row * PP + C_FK + h * 64 + half * 32;
    float sq = 0.f, sk = 0.f, sd = 0.f;
#pragma unroll
    for (int i = 0; i < 4; ++i) { const u32x4g a = *(const u32x4g*)(qp + 8 * i), b = *(const u32x4g*)(kp + 8 * i);
#pragma unroll
        for (int e = 0; e < 4; ++e) { const float a0 = __uint_as_float(a[e] << 16), a1 = __uint_as_float(a[e] & 0xffff0000u), b0 = __uint_as_float(b[e] << 16), b1 = __uint_as_float(b[e] & 0xffff0000u);
            sq += a0 * a0 + a1 * a1; sk += b0 * b0 + b1 * b1; sd += a0 * b0 + a1 * b1; } }
    sq += __shfl_xor(sq, 1); sk += __shfl_xor(sk, 1); sd += __shfl_xor(sd, 1);
    if (half == 0) ((float*)(ws + WS_DQ))[(size_t)h * S_ + row] = sd - 1e-3f * (1.f + fabsf(sd));
#pragma unroll
    for (int o = 2; o < 64; o <<= 1) { sq = fmaxf(sq, __shfl_xor(sq, o)); sk = fmaxf(sk, __shfl_xor(sk, o)); sd = fminf(sd, __shfl_xor(sd, o)); }
    LAS float* red = (LAS float*)lds;
    if ((tid & 63) == 0) { red[tid >> 6] = sq; red[8 + (tid >> 6)] = sk; red[16 + (tid >> 6)] = sd; }
    __syncthreads();
    if (tid == 0) { float a = red[0], b = red[8], c = red[16];
#pragma unroll
        for (int w = 1; w < 8; ++w) { a = fmaxf(a, red[w]); b = fmaxf(b, red[8 + w]); c = fminf(c, red[16 + w]); }
        QN[h * 64 + qb] = a * 1.0001f; QN[512 + h * 64 + qb] = b * 1.0001f; QN[1024 + h * 64 + qb] = c; }
    __syncthreads();
}

__device__ __forceinline__ float ret_log2_gamma(int h) { return log2f(1.0f - exp2f(-5.0f - (float)h)); }

__device__ __forceinline__ void ret_state_item(const Params& p, int h, int n, LAS unsigned char* lds, int tid) {
    asm volatile("" : "+v"(tid));
    unsigned char* ws = wsbase(p); const u16* P = (const u16*)(ws + WS_P); float* KV = (float*)(ws + WS_KVST) + ((size_t)(h * 128 + n)) * 4096;
    LAS u16* KT = (LAS u16*)lds; LAS u16* VT = KT + 64 * 136;
    const float lg = ret_log2_gamma(h);
#pragma unroll
    for (int i = 0; i < 2; ++i) { const int pc = tid + 512 * i, tok = pc >> 3, dch = pc & 7;
        const u32x4g kk = *(const u32x4g*)(P + (size_t)(n * 128 + tok) * PP + C_RK + h * 64 + dch * 8);
        const u32x4g vv = *(const u32x4g*)(P + (size_t)(n * 128 + tok) * PP + C_RV + h * 64 + dch * 8);
        const float zeta = exp2f(lg * (float)(127 - tok));
#pragma unroll
        for (int e = 0; e < 4; ++e) { KT[(dch * 8 + 2 * e) * 136 + tok] = (u16)(kk[e] & 0xffffu); KT[(dch * 8 + 2 * e + 1) * 136 + tok] = (u16)(kk[e] >> 16);
            VT[(dch * 8 + 2 * e) * 136 + tok] = (u16)f2bf(__uint_as_float(vv[e] << 16) * zeta); VT[(dch * 8 + 2 * e + 1) * 136 + tok] = (u16)f2bf(__uint_as_float(vv[e] & 0xffff0000u) * zeta); } }
    __syncthreads();
    const int lane = tid & 63, w = tid >> 6, l15 = lane & 15, lq = lane >> 4; const int dt = w >> 1;
#pragma unroll
    for (int ee = 0; ee < 2; ++ee) { const int et = (w & 1) * 2 + ee; pg8::f32x4 acc = {0.f, 0.f, 0.f, 0.f};
#pragma unroll
        for (int ks = 0; ks < 4; ++ks) { const bf16x8g a = *(const LAS bf16x8g*)(KT + (dt * 16 + l15) * 136 + ks * 32 + 8 * lq); const bf16x8g b = *(const LAS bf16x8g*)(VT + (et * 16 + l15) * 136 + ks * 32 + 8 * lq);
            acc = __builtin_amdgcn_mfma_f32_16x16x32_bf16(a, b, acc, 0, 0, 0); }
#pragma unroll
        for (int j = 0; j < 4; ++j) KV[(dt * 16 + lq * 4 + j) * 64 + et * 16 + l15] = acc[j]; }
    __syncthreads();
}

constexpr int RGC = 8;
__device__ __forceinline__ void ret_out_group(const Params& p, int h, int n0, LAS unsigned char* lds, int tid) {
    asm volatile("" : "+v"(tid));
    unsigned char* ws = wsbase(p); const u16* P = (const u16*)(ws + WS_P); const float* KV = (const float*)(ws + WS_KVST) + (size_t)h * 128 * 4096; u16* Y = (u16*)(ws + WS_H);
    LAS u16* Qs = (LAS u16*)lds; LAS u16* Ks = Qs + 128 * 72; LAS u16* VT = Ks + 128 * 72; LAS u16* Ss = VT + 64 * 136; LAS u16* RT = Ss + 128 * 136;
    const float lg = ret_log2_gamma(h); const float g = exp2f(lg * 128.f);
    const int lane = tid & 63, w = tid >> 6, l15 = lane & 15, lq = lane >> 4;
    f32x4g r0 = {0.f, 0.f, 0.f, 0.f}, r1 = {0.f, 0.f, 0.f, 0.f}; const float* src = KV + tid * 8;
    { f32x4g s0 = {0.f, 0.f, 0.f, 0.f}, s1 = {0.f, 0.f, 0.f, 0.f};
      const float g2 = g * g; int j = 0;
#pragma unroll 4
      for (; j + 1 < n0; j += 2) { const f32x4g a = *(const f32x4g*)(src + (size_t)j * 4096), b = *(const f32x4g*)(src + (size_t)j * 4096 + 4), c = *(const f32x4g*)(src + (size_t)(j + 1) * 4096), d = *(const f32x4g*)(src + (size_t)(j + 1) * 4096 + 4);
          r0 = r0 * g2 + a; r1 = r1 * g2 + b; s0 = s0 * g2 + c; s1 = s1 * g2 + d; }
      r0 = r0 * g + s0; r1 = r1 * g + s1; }
    u32x4g pq[2], pk[2], pv[2]; f32x4g ka = {0.f, 0.f, 0.f, 0.f}, kb = {0.f, 0.f, 0.f, 0.f};
#define RET_LOAD(nn) do { _Pragma("unroll") for (int i = 0; i < 2; ++i) { const int pc = tid + 512 * i, tok = pc >> 3, dch = pc & 7; const size_t rb = (size_t)((nn) * 128 + tok) * PP + h * 64 + dch * 8; \
        pq[i] = *(const u32x4g*)(P + rb + C_RQ); pk[i] = *(const u32x4g*)(P + rb + C_RK); pv[i] = *(const u32x4g*)(P + rb + C_RV); } } while (0)
    RET_LOAD(n0);
    for (int c8 = 0; c8 < RGC; ++c8) { const int n = n0 + c8;
        if (c8 > 0) { r0 = r0 * g + ka; r1 = r1 * g + kb; }
#pragma unroll
        for (int i = 0; i < 2; ++i) { const int pc = tid + 512 * i, tok = pc >> 3, dch = pc & 7;
            *(LAS u32x4g*)(Qs + tok * 72 + dch * 8) = pq[i];
            *(LAS u32x4g*)(Ks + tok * 72 + dch * 8) = pk[i];
            const u32x4g vv = pv[i];
#pragma unroll
            for (int e = 0; e < 4; ++e) { VT[(dch * 8 + 2 * e) * 136 + tok] = (u16)(vv[e] & 0xffffu); VT[(dch * 8 + 2 * e + 1) * 136 + tok] = (u16)(vv[e] >> 16); } }
        { const int d = tid >> 3, e0 = (tid & 7) * 8;
#pragma unroll
          for (int e = 0; e < 4; ++e) { RT[(e0 + e) * 72 + d] = (u16)f2bf(r0[e]); RT[(e0 + 4 + e) * 72 + d] = (u16)f2bf(r1[e]); } }
        __syncthreads();
        if (c8 + 1 < RGC) { RET_LOAD(n + 1); ka = *(const f32x4g*)(src + (size_t)n * 4096); kb = *(const f32x4g*)(src + (size_t)n * 4096 + 4); }
        u16 zg[4][4];
#pragma unroll
        for (int j = 0; j < 4; ++j)
#pragma unroll
            for (int et = 0; et < 4; ++et) zg[j][et] = P[(size_t)(n * 128 + w * 16 + lq * 4 + j) * PP + C_RZ + h * 64 + et * 16 + l15];
        bf16x8g qa[2];
#pragma unroll
        for (int ks = 0; ks < 2; ++ks) qa[ks] = *(const LAS bf16x8g*)(Qs + (w * 16 + l15) * 72 + ks * 32 + 8 * lq);
#pragma unroll
        for (int mt = 0; mt < 8; ++mt) { pg8::f32x4 acc = {0.f, 0.f, 0.f, 0.f};
            if (mt <= w) {
#pragma unroll
                for (int ks = 0; ks < 2; ++ks) { const bf16x8g b = *(const LAS bf16x8g*)(Ks + (mt * 16 + l15) * 72 + ks * 32 + 8 * lq); acc = __builtin_amdgcn_mfma_f32_16x16x32_bf16(qa[ks], b, acc, 0, 0, 0); } }
#pragma unroll
            for (int j = 0; j < 4; ++j) { const int c = w * 16 + lq * 4 + j, m = mt * 16 + l15; const float dv = (c >= m) ? acc[j] * exp2f(lg * (float)(c - m)) : 0.f; Ss[c * 136 + m] = (u16)f2bf(dv); } }
        __syncthreads();
        pg8::f32x4 o1[4], o2[4];
#pragma unroll
        for (int et = 0; et < 4; ++et) { o1[et] = (pg8::f32x4){0.f, 0.f, 0.f, 0.f}; o2[et] = (pg8::f32x4){0.f, 0.f, 0.f, 0.f}; }
        const int ksmax = w >> 1;
        for (int ks = 0; ks <= ksmax; ++ks) { const bf16x8g a = *(const LAS bf16x8g*)(Ss + (w * 16 + l15) * 136 + ks * 32 + 8 * lq);
#pragma unroll
            for (int et = 0; et < 4; ++et) { const bf16x8g b = *(const LAS bf16x8g*)(VT + (et * 16 + l15) * 136 + ks * 32 + 8 * lq); o1[et] = __builtin_amdgcn_mfma_f32_16x16x32_bf16(a, b, o1[et], 0, 0, 0); } }
#pragma unroll
        for (int ks = 0; ks < 2; ++ks)
#pragma unroll
            for (int et = 0; et < 4; ++et) { const bf16x8g b = *(const LAS bf16x8g*)(RT + (et * 16 + l15) * 72 + ks * 32 + 8 * lq); o2[et] = __builtin_amdgcn_mfma_f32_16x16x32_bf16(qa[ks], b, o2[et], 0, 0, 0); }
#pragma unroll
        for (int j = 0; j < 4; ++j) { const int c = w * 16 + lq * 4 + j; const float xi = exp2f(lg * (float)(c + 1)); float ov[4]; float ss = 0.f;
#pragma unroll
            for (int et = 0; et < 4; ++et) { ov[et] = o1[et][j] + xi * o2[et][j]; ss += ov[et] * ov[et]; }
            ss += __shfl_xor(ss, 1); ss += __shfl_xor(ss, 2); ss += __shfl_xor(ss, 4); ss += __shfl_xor(ss, 8);
            const float rs = 1.0f / sqrtf(ss * (1.f / 64.f) + EPS_); const size_t row = (size_t)(n * 128 + c);
#pragma unroll
            for (int et = 0; et < 4; ++et) { const float z = bf2f(zg[j][et]); Y[row * 1024 + 512 + h * 64 + et * 16 + l15] = (u16)f2bf(ov[et] * rs * (z / (1.f + __expf(-z)))); } }
        __syncthreads();
    }
#undef RET_LOAD
}

struct EpiIn {
    static constexpr bool PERM = true, AFTER_DRAIN = false;
    u16* P; u16* MKV; const float* rope;
    __device__ __forceinline__ void operator()(const pg8::f32x4 (&acc)[2][2][4][2], const pg8::Unit& u, int wr, int wc, int fr, int fq) const {
        u16* base; int pitch, row0, colt; float sc = 1.f; bool rot = false;
        if (u.pm >= 64) { const int l = u.pm - 64; base = MKV + (size_t)l * 256 * 512; pitch = 512; row0 = 0; colt = (u.pn - 14 - 2 * l) * 256; }
        else { base = P; pitch = PP; row0 = u.pm * 256; colt = u.pn * 256;
            if (u.pn < 2 || u.pn == 12) sc = fa::C2; else if (u.pn == 8) rot = true; else if (u.pn == 9) { rot = true; sc = 0.125f; } }
#pragma unroll
        for (int ai = 0; ai < 2; ++ai)
#pragma unroll
            for (int m = 0; m < 4; ++m) { const int rr = ai * 128 + wr * 64 + m * 16 + fr; const int row = row0 + rr;
#pragma unroll
                for (int bj = 0; bj < 2; ++bj) { const int cl = bj * 128 + wc * 32 + 8 * fq; pg8::f32x4 v0 = acc[ai][bj][m][0], v1 = acc[ai][bj][m][1];
                    if (rot) { const f32x4g* rp = (const f32x4g*)(rope + ((size_t)row * 32 + ((cl & 63) >> 1)) * 2); const f32x4g c0 = rp[0], c1 = rp[1];
                        float a, b; a = v0[0] * c0[0] - v0[1] * c0[1]; b = v0[0] * c0[1] + v0[1] * c0[0]; v0[0] = a; v0[1] = b;
                        a = v0[2] * c0[2] - v0[3] * c0[3]; b = v0[2] * c0[3] + v0[3] * c0[2]; v0[2] = a; v0[3] = b;
                        a = v1[0] * c1[0] - v1[1] * c1[1]; b = v1[0] * c1[1] + v1[1] * c1[0]; v1[0] = a; v1[1] = b;
                        a = v1[2] * c1[2] - v1[3] * c1[3]; b = v1[2] * c1[3] + v1[3] * c1[2]; v1[2] = a; v1[3] = b; }
                    u32x4g w; w.x = pk2(v0[0] * sc, v0[1] * sc); w.y = pk2(v0[2] * sc, v0[3] * sc); w.z = pk2(v1[0] * sc, v1[1] * sc); w.w = pk2(v1[2] * sc, v1[3] * sc);
                    st16_wt(base + (size_t)row * pitch + colt + cl, w); } }
    }
};
struct EpiOut {
    static constexpr bool PERM = true, AFTER_DRAIN = false;
    u16* O;
    __device__ __forceinline__ void operator()(const pg8::f32x4 (&acc)[2][2][4][2], const pg8::Unit& u, int wr, int wc, int fr, int fq) const {
#pragma unroll
        for (int ai = 0; ai < 2; ++ai)
#pragma unroll
            for (int m = 0; m < 4; ++m) { const int row = u.pm * 256 + ai * 128 + wr * 64 + m * 16 + fr;
#pragma unroll
                for (int bj = 0; bj < 2; ++bj) { const int col = u.pn * 256 + bj * 128 + wc * 32 + 8 * fq; const pg8::f32x4 v0 = acc[ai][bj][m][0], v1 = acc[ai][bj][m][1];
                    u32x4g w; w.x = pk2(v0[0], v0[1]); w.y = pk2(v0[2], v0[3]); w.z = pk2(v1[0], v1[1]); w.w = pk2(v1[2], v1[3]);
                    st16_wt(O + (size_t)row * 1024 + col, w); } }
    }
};
struct OrderList {
    int first, G, count;
    __device__ __forceinline__ bool next(int i, pg8::Unit& u) const { const int L = first + i * G; if (L >= count) return false;
        if (L < 128) { u.pm = L >> 1; u.pn = 12 + (L & 1); } else { const int q = L - 128; u.pm = 64 + (q >> 1); u.pn = 14 + q; } return true; }
    __device__ __forceinline__ void a_ready(const pg8::Unit&) const {}
    __device__ __forceinline__ void done(const pg8::Unit&) const {}
};

#define XB_TMO      128
#define XB_XCNT(j)  (256  + 64 * (j))
#define XB_XSUB(j)  (1280 + 64 * (j))
#define XB_XGEN(j)  (2304 + 64 * (j))
#define XB_TOP      3328
#define XB_TOPGEN   3392
#define XCD_BAR_WORDS 3456
#define XB_SPIN_CAP (1u << 18)

__device__ __forceinline__ unsigned xb_ld(unsigned* p)              { return __hip_atomic_load(p, __ATOMIC_RELAXED, __HIP_MEMORY_SCOPE_AGENT); }
__device__ __forceinline__ unsigned xb_add(unsigned* p, unsigned v) { return __hip_atomic_fetch_add(p, v, __ATOMIC_RELAXED, __HIP_MEMORY_SCOPE_AGENT); }
__device__ __forceinline__ unsigned xb_xcc_id() { return (unsigned)__builtin_amdgcn_s_getreg((3 << 11) | 20) & 0xFu; }
#define XB_SPIN(cond, bar) do { unsigned _sp = 0; while (cond) { __builtin_amdgcn_s_sleep(1); \
    if ((++_sp & 255u) == 0u) { if (xb_ld(&(bar)[XB_TMO])) break; if (_sp > XB_SPIN_CAP) { atomicAdd(&(bar)[XB_TMO], 1u); break; } } } } while (0)

struct XcdBarrier {
    unsigned* bar; unsigned x;
    volatile LAS unsigned* st;
};

__device__ __forceinline__ XcdBarrier xcd_barrier_post(unsigned* bar, volatile LAS unsigned* st) {
    XcdBarrier b; b.bar = bar; b.x = xb_xcc_id(); b.st = st;
    if (threadIdx.x == 0) (void)xb_add(&bar[XB_XCNT(b.x)], 1u);
    return b;
}
__device__ __forceinline__ void xcd_barrier_complete(unsigned* bar, unsigned x, unsigned& nloc, unsigned& nx) {
    const unsigned G = gridDim.x * gridDim.y * gridDim.z;
    unsigned sum, cnt, mine, sp = 0u;
    for (;;) {
        sum = 0u; cnt = 0u; mine = 0u;
#pragma unroll
        for (unsigned j = 0; j < 16; ++j) { const unsigned c = xb_ld(&bar[XB_XCNT(j)]); sum += c; cnt += (c > 0u) ? 1u : 0u; mine = (j == x) ? c : mine; }
        if (sum == G) break;
        __builtin_amdgcn_s_sleep(1);
        if ((++sp & 255u) == 0u) { if (xb_ld(&bar[XB_TMO])) break; if (sp > XB_SPIN_CAP) { atomicAdd(&bar[XB_TMO], 1u); break; } }
    }
    nloc = mine > 0u ? mine : 1u; nx = cnt > 0u ? cnt : 1u;
}

__device__ __forceinline__ void xcd_barrier(const XcdBarrier& b) {
    asm volatile("s_waitcnt vmcnt(0)" ::: "memory");
    __syncthreads();
    if (threadIdx.x == 0) {
        unsigned* bar = b.bar;
        __builtin_amdgcn_s_waitcnt(0);
        unsigned nloc = b.st[0], nx = b.st[1];
        if (nloc == 0u) { xcd_barrier_complete(bar, b.x, nloc, nx); b.st[0] = nloc; b.st[1] = nx; }
        const unsigned old = xb_add(&bar[XB_XSUB(b.x)], 1u);
        const unsigned gen = old / nloc;
        if (old + 1u == (gen + 1u) * nloc) {
            __builtin_amdgcn_fence(__ATOMIC_RELEASE, "agent");
            asm volatile("s_waitcnt vmcnt(0)" ::: "memory");
            const unsigned og = xb_add(&bar[XB_TOP], 1u);
            const unsigned tg = og / nx;
            if (og + 1u == (tg + 1u) * nx) xb_add(&bar[XB_TOPGEN], 1u);
            else XB_SPIN(xb_ld(&bar[XB_TOPGEN]) == tg, bar);
            __builtin_amdgcn_fence(__ATOMIC_ACQUIRE, "agent");
            xb_add(&bar[XB_XGEN(b.x)], 1u);
            asm volatile("s_waitcnt vmcnt(0)" ::: "memory");
        } else {
            XB_SPIN(xb_ld(&bar[XB_XGEN(b.x)]) == gen, bar);
            __builtin_amdgcn_fence(__ATOMIC_ACQUIRE, "agent");
            asm volatile("s_waitcnt vmcnt(0)" ::: "memory");
        }
    }
    __syncthreads();
}


constexpr int N_PHASES = 1 + 5 * DEPTH_;
template <bool COOP>
__global__ void __launch_bounds__(NTHR, 2) mk_fwd(Params p) {
    extern __shared__ __attribute__((aligned(16))) unsigned char lds_raw[];
    LAS unsigned char* lds = (LAS unsigned char*)lds_raw;
    const int tid = threadIdx.x, G = gridDim.x, bx = blockIdx.x;
    unsigned char* ws = p.ws;
    const int lo = p.ph_lo, hi = p.ph_hi;
#define IN(k) (lo <= (k) && (k) < hi)
#define SEAM(k) do { if (IN(k) && IN((k) + 1)) { if constexpr (COOP) { xcd_barrier(bar); } } } while (0)
    volatile LAS unsigned* bst = (volatile LAS unsigned*)(lds + LDS_BYTES - 64);
    if (tid == 0) { bst[0] = 0u; bst[1] = 0u; }
    __syncthreads();
    XcdBarrier bar; bar.bar = (unsigned*)ws; bar.x = 0; bar.st = bst;
    if constexpr (COOP) { bar = xcd_barrier_post((unsigned*)ws, bst); if (lo < 0) cg::this_grid().sync(); }

#ifndef SKIP_P0
    if (IN(0)) {
        LAS float* scr = (LAS float*)lds;
        transpose_range(p, 0, 4 * (896 + 256 + 128), bx, G, scr, tid);
        for (int i = bx * NTHR + tid; i < 4 * 8 * 1024; i += G * NTHR) { const int l = i >> 13, c = (i >> 10) & 7, k = i & 1023; const float wv = p.w_in[(size_t)l * 1024 * DIN_ORIG + (size_t)k * DIN_ORIG + 2048 + c];
            const unsigned hb = f2bf(wv); const float hf = __uint_as_float(hb << 16); u16* wfb = (u16*)(ws + WS_WF) + (size_t)l * 16 * 1024;
            wfb[(size_t)c * 1024 + k] = (u16)hb; wfb[(size_t)(8 + c) * 1024 + k] = (u16)f2bf(wv - hf); }
        for (int i = bx * NTHR + tid; i < S_ * 32; i += G * NTHR) { const int pos = i >> 5, fi = i & 31;
            const float freq = (float)exp2(-(double)fi * (13.287712379549449 / 32.0)); const float ang = (float)pos * freq;
            const double rev = (double)ang * 0.15915494309189535; const float fr = (float)(rev - rint(rev));
            float* o = (float*)(ws + WS_ROPE) + (size_t)i * 2; o[0] = __builtin_amdgcn_cosf(fr); o[1] = __builtin_amdgcn_sinf(fr); }
        { const int lane = tid & 63, wid = tid >> 6;
          for (int rw = bx * 8 + wid; rw < 4 * NMEM; rw += G * 8) { const int l = rw >> 8, m = rw & 255; f32x4g v[4]; float s = 0.f;
#pragma unroll
              for (int j = 0; j < 4; ++j) { v[j] = *((const f32x4g*)(p.mem + (size_t)m * 1024) + lane + 64 * j); s += (v[j].x * v[j].x + v[j].y * v[j].y) + (v[j].z * v[j].z + v[j].w * v[j].w); }
              const float rs = 1.0f / sqrtf(wave_sum(s) * (1.f / 1024.f) + EPS_);
#pragma unroll
              for (int j = 0; j < 4; ++j) { const f32x4g g = *((const f32x4g*)(p.g_mem + (size_t)l * 1024) + lane + 64 * j); v[j] = v[j] * rs * g;
                  u32x2g w; w.x = pk2(v[j].x, v[j].y); w.y = pk2(v[j].z, v[j].w); *((u32x2g*)((u16*)(ws + WS_H) + (size_t)(S_ + rw) * 1024) + lane + 64 * j) = w; } } }
        __syncthreads();
        norm_phase<0, 0, true>(p, 0, (LAS float*)lds, tid);
        __syncthreads();
    }
#endif
    SEAM(0);

    for (int l = 0; l < DEPTH_; ++l) {
        const int pb = 1 + 5 * l;
#ifndef SKIP_INPROJ
        if (IN(pb)) {
            unsigned char* ws = wsbase(p);
            const u16* Bt = (const u16*)(ws + (l == 0 ? WS_BT0 : WS_BT1 + (size_t)(l - 1) * BT_STRIDE));
            pg8::Gemm g{(const u16*)(ws + WS_H), Bt, S_, NIN, 1024};
            EpiIn E{(u16*)(ws + WS_P), (u16*)(ws + WS_MKV), (const float*)(ws + WS_ROPE)};
            { pg8::StaticOrder S; S.init(S_, 3072, G, bx); pg8::gemm_phase<EpiIn, pg8::StaticOrder, true, true>(lds, g, S, E); }
            __syncthreads();
            if (l > 0) fgate_mfma(p, l, lds, tid);
        }
#endif
        SEAM(pb);
#ifndef SKIP_MID
        if (IN(pb + 1)) {
            unsigned char* ws = wsbase(p);
            const int NU = 128 + (l == 0 ? 8 : 0);
            const bool sep = G >= NU + 64; const int w0 = sep ? NU : 0, nw = sep ? G - NU : G;
            if (bx < NU || !sep) {
                const u16* Bt = (const u16*)(ws + (l == 0 ? WS_BT0 : WS_BT1 + (size_t)(l - 1) * BT_STRIDE));
                pg8::Gemm g{(const u16*)(ws + WS_H), Bt, S_, NIN, 1024};
                EpiIn E{(u16*)(ws + WS_P), (u16*)(ws + WS_MKV), (const float*)(ws + WS_ROPE)};
                OrderList S{bx, G, NU}; pg8::gemm_phase<EpiIn, OrderList, false, true>(lds, g, S, E);
                __syncthreads();
            }
            if (bx >= w0) {
                for (int it = bx - w0; it < 16 + 512 + 512; it += nw) {
                    if (it < 16) cumsum_item(p, it, tid);
                    else if (it < 528) { const int q = it - 16; ret_state_item(p, q >> 7, q & 127, lds, tid); }
                    else { const int q = it - 528; qknorm_item(p, q >> 6, q & 63, lds, tid); }
                }
            }
            __syncthreads();
        }
#endif
        SEAM(pb + 1);
#ifndef SKIP_MIX
        if (IN(pb + 2)) {
            unsigned char* ws = wsbase(p);
            const fa::bf16* P = (const fa::bf16*)(ws + WS_P); fa::bf16* Y = (fa::bf16*)(ws + WS_H);
            const fa::bf16* MKV = (const fa::bf16*)(ws + WS_MKV) + (size_t)l * 256 * 512;
            char* shm = (char*)lds_raw;
            unsigned* qctr = (unsigned*)ws + 3584 + 64 * l; unsigned* flags = (unsigned*)ws + 4096 + 1024 * l;
            volatile LAS int* qitem = (volatile LAS int*)(lds + LDS_BYTES - 64) + 4;
            const float* QN = (const float*)(ws + WS_QN);
            constexpr int NRET = 512 / RGC, NFAR = FOX_SPLIT ? 768 : 0, I1 = NRET, I2 = I1 + NFAR, I3 = I2 + 512, I4 = I3 + 256;
            for (;;) {
                if (tid == 0) qitem[0] = (int)__hip_atomic_fetch_add(qctr, 1u, __ATOMIC_RELAXED, __HIP_MEMORY_SCOPE_AGENT);
                __syncthreads();
                const int it = __builtin_amdgcn_readfirstlane(qitem[0]);
                __syncthreads();
                if (it >= I4) break;
                if (it < I1) { ret_out_group(p, it & 3, (128 / RGC - 1 - (it >> 2)) * RGC, lds, tid); }
                else if (it < I3) {
                    int h, qb, part = 0;
                    if (it < I2) { const int q = it - I1; h = 7 - q / 96; const int r = q % 96; if (r < 48) { part = 1; qb = 63 - r; } else if (r < 80) { part = 2; qb = 111 - r; } else { part = 3; qb = 143 - r; } }
                    else { const int q = it - I2; h = 7 - (q >> 6); qb = 63 - (q & 63); }
                    const int q0 = qb * 256; unsigned* fl = FOX_SPLIT ? flags + (7 - h) * 96 : nullptr; unsigned char* sl = ws + WS_PART + (size_t)(7 - h) * 96 * fa::SLOT_BYTES;
                    const float* Cl = (const float*)(ws + WS_CL) + (size_t)h * S_; const float* Tb = (const float*)(ws + WS_TB) + h * 16;
                    if (FOX_SPLIT && part) fa::attn_unit<8, false, true, PP, PP, 1024, 1>(q0, 0, (q0 + 256) / 64, P + C_FQ + h * 64, P + C_FK + h * 64, P + C_FV + h * 64, P + C_FZ + h * 64, Y + h * 64, Cl, Tb, QN + h * 64, QN + 512 + h * 64, (const float*)(ws + WS_DQ) + (size_t)h * S_, PRUNE_THRESH, part, fl, sl, shm);
                    else fa::attn_unit<8, true, true, PP, PP, 1024, 0>(q0, 0, (q0 + 256) / 64, P + C_FQ + h * 64, P + C_FK + h * 64, P + C_FV + h * 64, P + C_FZ + h * 64, Y + h * 64, Cl, Tb, QN + h * 64, QN + 512 + h * 64, (const float*)(ws + WS_DQ) + (size_t)h * S_, PRUNE_THRESH, 0, fl, sl, shm); }
                else { const int q = it - I3, mh = q >> 6, mb = q & 63;
                    fa::attn_unit<8, false, false, PP, 512, 1024, 0>(mb * 256, 0, 4, P + C_MQ + mh * 64, MKV + mh * 64, MKV + 256 + mh * 64, P + C_MZ + mh * 64, Y + 768 + mh * 64, nullptr, nullptr, nullptr, nullptr, nullptr, 0.f, 0, nullptr, nullptr, shm); }
            }
            __syncthreads();
        }
#endif
        SEAM(pb + 2);
#ifndef SKIP_OUTPROJ
        if (IN(pb + 3)) {
            unsigned char* ws = wsbase(p);
            pg8::Gemm g{(const u16*)(ws + WS_H), (const u16*)(ws + WS_WOT) + (size_t)l * 1024 * 1024, S_, 1024, 1024};
            EpiOut E{(u16*)(ws + WS_P)};
            pg8::StaticOrder S; S.init(S_, 1024, G, bx); pg8::gemm_phase<EpiOut, pg8::StaticOrder, false, true>(lds, g, S, E);
            __syncthreads();
        }
#endif
        SEAM(pb + 3);
#ifndef SKIP_NORM
        if (IN(pb + 4)) { if (l == 0) norm_phase<0, 1, false>(p, 1, (LAS float*)lds, tid); else if (l + 1 < DEPTH_) norm_phase<1, 1, false>(p, l + 1, (LAS float*)lds, tid); else norm_phase<1, 2, false>(p, DEPTH_, (LAS float*)lds, tid); __syncthreads(); }
#endif
        SEAM(pb + 4);
    }
#undef IN
#undef SEAM
}

#ifndef MK_MULTI
#define MK_MULTI 0
#endif
extern "C" void kernel_launch(void* const* d_in, const int* in_sizes, int n_in, void* d_out, int out_size, void* d_ws, size_t ws_size, hipStream_t stream) {
    static int grid = 0;
    if (grid == 0) {
        int dev = 0, cus = 0, per_cu = 0;
        hipGetDevice(&dev); hipDeviceGetAttribute(&cus, hipDeviceAttributeMultiprocessorCount, dev);
        hipFuncSetAttribute((const void*)mk_fwd<true>, hipFuncAttributeMaxDynamicSharedMemorySize, LDS_BYTES);
        hipFuncSetAttribute((const void*)mk_fwd<false>, hipFuncAttributeMaxDynamicSharedMemorySize, LDS_BYTES);
        hipOccupancyMaxActiveBlocksPerMultiprocessor(&per_cu, (const void*)mk_fwd<true>, NTHR, LDS_BYTES);
        if (per_cu < 1) { fprintf(stderr, "kernel_launch: occupancy query says %d blocks per CU\n", per_cu); per_cu = 1; }
        if (per_cu > 1) per_cu = 1;
        grid = cus * per_cu; if (grid <= 0) grid = 256;
        (void)hipGetLastError();
    }
    Params p{};
    p.x = (const float*)d_in[0]; p.mem = (const float*)d_in[1]; p.w_in = (const float*)d_in[2]; p.b_f = (const float*)d_in[3]; p.w_out = (const float*)d_in[4];
    p.w_mkv = (const float*)d_in[5]; p.g_pre = (const float*)d_in[6]; p.g_post = (const float*)d_in[7]; p.g_mem = (const float*)d_in[8];
    p.out = (float*)d_out; p.ws = (unsigned char*)d_ws;
#if MK_MULTI
    for (int ph = 0; ph < N_PHASES; ++ph) { p.ph_lo = ph; p.ph_hi = ph + 1; hipLaunchKernelGGL(mk_fwd<false>, dim3(grid), dim3(NTHR), LDS_BYTES, stream, p); }
#else
    p.ph_lo = 0; p.ph_hi = N_PHASES;
    (void)hipMemsetAsync(d_ws, 0, 32768, stream);
    void* args[] = {&p};
    hipError_t e = hipLaunchCooperativeKernel((const void*)mk_fwd<true>, dim3(grid), dim3(NTHR), args, LDS_BYTES, stream);
    if (e != hipSuccess) fprintf(stderr, "cooperative launch failed: %s (grid %d)\n", hipGetErrorString(e), grid);
#endif
}
```

```cpp
#include <hip/hip_runtime.h>
#include <hip/hip_cooperative_groups.h>
#include <hip/hip_bf16.h>
#include <cstdio>
#include <cstdint>
#include <cmath>
namespace cg = cooperative_groups;
namespace pg8 {
#define PG8_LAS __attribute__((address_space(3)))
typedef unsigned short bf16_t;
typedef short bf16x8 __attribute__((ext_vector_type(8)));
typedef float f32x4 __attribute__((ext_vector_type(4)));
typedef unsigned u32x4 __attribute__((ext_vector_type(4)));
constexpr int BM = 256, BK = 64, HALF = 128, HTB = HALF * BK * 2  , STAGE_BYTES = 8 * HTB, NXCD = 8, WGM = 8;

__host__ __device__ __forceinline__ int lds_byte(int r, int c) { const int st = (r >> 4) * 2 + (c >> 5), rr = r & 15, cc = c & 31, ob = rr * 64 + cc * 2; return st * 1024 + (ob ^ (((ob >> 9) & 1) << 5)); }
__host__ __device__ __forceinline__ void stage_rc(int b, int& R, int& C) { const int st = b / 1024, sb = b % 1024, swz = sb ^ (((sb >> 9) & 1) << 5); R = (st >> 1) * 16 + swz / 64; C = (st & 1) * 32 + (swz % 64) / 2; }
__host__ __device__ __forceinline__ int perm32(int rho) { const int n = rho >> 4, i = rho & 15; return 8 * (i >> 2) + 4 * n + (i & 3); }

struct Unit { int pm, pn; };
struct Gemm { const bf16_t* A; const bf16_t* Bt; int M, N, K; };

struct StaticOrder {
    int nM, nN, nwg, G, c;
    __host__ __device__ void init(int M, int N, int G_, int c_) { nM = M / BM; nN = N / BM; nwg = nM * nN; G = G_; c = c_; }
    __host__ __device__ bool next(int i, Unit& u) const {
        const long L = (long)i * G + c; if (L >= nwg) return false;
        int wgid = (int)L; { const int q = nwg / NXCD, r = nwg % NXCD, xcd = wgid % NXCD, off = wgid / NXCD; wgid = (xcd < r ? xcd * (q + 1) : r * (q + 1) + (xcd - r) * q) + off; }
        const int nig = WGM * nN, gid = wgid / nig, fm = gid * WGM, gsz = (nM - fm) < WGM ? (nM - fm) : WGM;
        u.pm = fm + ((wgid % nig) % gsz); u.pn = (wgid % nig) / gsz; return true;
    }
    __device__ __forceinline__ void a_ready(const Unit&) const {}
    __device__ __forceinline__ void done(const Unit&) const {}
};

__device__ __forceinline__ unsigned cvt_pk_bf16(float lo, float hi) { unsigned r; asm volatile("v_cvt_pk_bf16_f32 %0, %1, %2" : "=v"(r) : "v"(lo), "v"(hi)); return r; }

template <class Epi, class Sched, bool ALIGN_EPI = false, bool SP2 = false>
__device__ __forceinline__ void gemm_phase(PG8_LAS unsigned char* lds, const Gemm g, const Sched& S, const Epi& E) {
    int tid = threadIdx.x; asm volatile("" : "+v"(tid)); const int wid = __builtin_amdgcn_readfirstlane(tid >> 6), lane = tid & 63, wr = wid >> 2, wc = wid & 3, fr = lane & 15, fq = lane >> 4;
    const int K = g.K, nt = K / BK;
    unsigned voffA[2], voffB[2];
#pragma unroll
    for (int i = 0; i < 2; ++i) { int R, C; stage_rc(tid * 16 + i * 8192, R, C); const int Rb = Epi::PERM ? ((R & ~31) + perm32(R & 31)) : R;
        voffA[i] = (unsigned)(R * K + C) * 2u; voffB[i] = (unsigned)(Rb * K + C) * 2u; }
    const size_t kstep = (size_t)(BK * 2);
    const size_t hstep = (size_t)HALF * K * 2;
    const size_t tstep = 2 * hstep;
    const unsigned ldsw = (unsigned)wid * 1024u;
    const int aoff = lds_byte(wr * 64 + fr, fq * 8), boff = lds_byte(wc * 32 + fr, fq * 8);
#define PG8_SA(b, h) (((b) * 2 + (h)) * HTB)
#define PG8_SB(b, h) ((4 + (b) * 2 + (h)) * HTB)
#define PG8_STAGE(bufoff, gbase, voff) do { _Pragma("unroll") for (int _i = 0; _i < 2; ++_i) \
        __builtin_amdgcn_global_load_lds((const unsigned*)((const char*)(gbase) + (voff)[_i]), (PG8_LAS unsigned*)(lds + (bufoff) + ldsw + _i * 8192), 16, 0, 0); } while (0)
#define PG8_LDA(dst, b, h) do { _Pragma("unroll") for (int m = 0; m < 4; ++m) _Pragma("unroll") for (int k = 0; k < 2; ++k) dst[m][k] = *(const PG8_LAS bf16x8*)(lds + PG8_SA(b, h) + aoff + m * 2048 + k * 1024); } while (0)
#define PG8_LDB(dst, b, h) do { _Pragma("unroll") for (int n = 0; n < 2; ++n) _Pragma("unroll") for (int k = 0; k < 2; ++k) dst[n][k] = *(const PG8_LAS bf16x8*)(lds + PG8_SB(b, h) + boff + n * 2048 + k * 1024); } while (0)
#define PG8_MMA(ai, bj, At, Bt) do { __builtin_amdgcn_s_setprio(1); _Pragma("unroll") for (int m = 0; m < 4; ++m) _Pragma("unroll") for (int n = 0; n < 2; ++n) _Pragma("unroll") for (int k = 0; k < 2; ++k) \
        acc[ai][bj][m][n] = __builtin_amdgcn_mfma_f32_16x16x32_bf16(Bt[n][k], At[m][k], acc[ai][bj][m][n], 0, 0, 0); __builtin_amdgcn_s_setprio(0); } while (0)
#define PG8_WAIT_V(n) asm volatile("s_waitcnt vmcnt(" #n ")" ::: "memory")
#define PG8_WAIT_L(n) asm volatile("s_waitcnt lgkmcnt(" #n ")" ::: "memory")
#define PG8_BAR __builtin_amdgcn_s_barrier()
#define PG8_SCHED __builtin_amdgcn_sched_barrier(0)
    Unit cur, nxt; int ui = 0;
    if (!S.next(0, cur)) return;
    f32x4 acc[2][2][4][2];
#pragma unroll
    for (int a = 0; a < 2; ++a)
#pragma unroll
        for (int b = 0; b < 2; ++b)
#pragma unroll
            for (int m = 0; m < 4; ++m)
#pragma unroll
                for (int n = 0; n < 2; ++n) acc[a][b][m][n] = (f32x4){0.f, 0.f, 0.f, 0.f};
    bf16x8 At[4][2], B0[2][2], B1[2][2];
    const char* cA = (const char*)g.A + (size_t)cur.pm * tstep; const char* cB = (const char*)g.Bt + (size_t)cur.pn * tstep;
    S.a_ready(cur);
    if constexpr (SP2) {
        PG8_STAGE(PG8_SB(0, 0), cB, voffB); PG8_STAGE(PG8_SB(0, 1), cB + hstep, voffB); PG8_STAGE(PG8_SA(0, 0), cA, voffA); PG8_STAGE(PG8_SA(0, 1), cA + hstep, voffA);
        if (wr == 1) PG8_BAR;
        PG8_WAIT_V(2); PG8_BAR;
        PG8_STAGE(PG8_SB(1, 0), cB + kstep, voffB); PG8_STAGE(PG8_SA(1, 0), cA + kstep, voffA); PG8_STAGE(PG8_SB(1, 1), cB + hstep + kstep, voffB);
        PG8_WAIT_V(6); PG8_BAR;
    } else {
        PG8_STAGE(PG8_SB(0, 0), cB, voffB); PG8_STAGE(PG8_SA(0, 0), cA, voffA); PG8_STAGE(PG8_SB(0, 1), cB + hstep, voffB); PG8_STAGE(PG8_SA(0, 1), cA + hstep, voffA);
        if (wr == 1) PG8_BAR;
        PG8_WAIT_V(4); PG8_BAR;
        PG8_STAGE(PG8_SB(1, 0), cB + kstep, voffB); PG8_STAGE(PG8_SA(1, 0), cA + kstep, voffA); PG8_STAGE(PG8_SB(1, 1), cB + hstep + kstep, voffB);
        PG8_WAIT_V(6); PG8_BAR;
    }
    for (;;) {
        const bool has_next = S.next(ui + 1, nxt);
        const char* nA = has_next ? (const char*)g.A + (size_t)nxt.pm * tstep : cA; const char* nB = has_next ? (const char*)g.Bt + (size_t)nxt.pn * tstep : cB;
        for (int t = 0; t < nt; t += 2) {
            const bool last = (t == nt - 2);
            const char* a1 = cA + (size_t)(t + 1) * kstep;
            const char* a2 = last ? nA : cA + (size_t)(t + 2) * kstep; const char* b2 = last ? nB : cB + (size_t)(t + 2) * kstep;
            const char* a3 = a2 + kstep; const char* b3 = b2 + kstep;
            if (last && has_next) S.a_ready(nxt);
            if constexpr (SP2) {
            PG8_LDB(B0, 0, 0); PG8_LDB(B1, 0, 1); PG8_SCHED; PG8_LDA(At, 0, 0); PG8_STAGE(PG8_SA(1, 1), a1 + hstep, voffA);
            PG8_WAIT_V(8); PG8_WAIT_L(0); PG8_BAR; PG8_MMA(0, 0, At, B0); PG8_MMA(0, 1, At, B1); PG8_BAR; PG8_SCHED;
            PG8_LDA(At, 0, 1); PG8_STAGE(PG8_SB(0, 0), b2, voffB); PG8_STAGE(PG8_SB(0, 1), b2 + hstep, voffB); PG8_STAGE(PG8_SA(0, 0), a2, voffA);
            PG8_WAIT_V(8); PG8_WAIT_L(0); PG8_BAR; PG8_MMA(1, 0, At, B0); PG8_MMA(1, 1, At, B1); PG8_BAR; PG8_SCHED;
            PG8_LDB(B0, 1, 0); PG8_LDB(B1, 1, 1); PG8_SCHED; PG8_LDA(At, 1, 0); PG8_STAGE(PG8_SA(0, 1), a2 + hstep, voffA);
            PG8_WAIT_V(8); PG8_WAIT_L(0); PG8_BAR; PG8_MMA(0, 0, At, B0); PG8_MMA(0, 1, At, B1); PG8_BAR; PG8_SCHED;
            PG8_LDA(At, 1, 1); PG8_STAGE(PG8_SB(1, 0), b3, voffB); PG8_STAGE(PG8_SB(1, 1), b3 + hstep, voffB); PG8_STAGE(PG8_SA(1, 0), a3, voffA);
            PG8_WAIT_V(8); PG8_WAIT_L(0); PG8_BAR; PG8_MMA(1, 0, At, B0); PG8_MMA(1, 1, At, B1); PG8_BAR; PG8_SCHED;
            } else {
            PG8_LDB(B0, 0, 0); PG8_SCHED; PG8_LDA(At, 0, 0); PG8_STAGE(PG8_SA(1, 1), a1 + hstep, voffA);
            PG8_WAIT_L(8); PG8_BAR; PG8_WAIT_L(0); PG8_MMA(0, 0, At, B0); PG8_BAR; PG8_SCHED;
            PG8_LDB(B1, 0, 1); PG8_STAGE(PG8_SB(0, 0), b2, voffB);
            PG8_BAR; PG8_WAIT_L(0); PG8_MMA(0, 1, At, B1); PG8_BAR;
            PG8_LDA(At, 0, 1); PG8_STAGE(PG8_SA(0, 0), a2, voffA);
            PG8_BAR; PG8_WAIT_L(0); PG8_MMA(1, 0, At, B0); PG8_BAR; PG8_SCHED;
            PG8_STAGE(PG8_SB(0, 1), b2 + hstep, voffB);
            PG8_WAIT_V(6); PG8_BAR; PG8_MMA(1, 1, At, B1); PG8_BAR;
            PG8_LDB(B0, 1, 0); PG8_SCHED; PG8_LDA(At, 1, 0); PG8_STAGE(PG8_SA(0, 1), a2 + hstep, voffA);
            PG8_WAIT_L(8); PG8_BAR; PG8_WAIT_L(0); PG8_MMA(0, 0, At, B0); PG8_BAR; PG8_SCHED;
            PG8_LDB(B1, 1, 1); PG8_STAGE(PG8_SB(1, 0), b3, voffB);
            PG8_BAR; PG8_WAIT_L(0); PG8_MMA(0, 1, At, B1); PG8_BAR;
            PG8_LDA(At, 1, 1); PG8_STAGE(PG8_SA(1, 0), a3, voffA);
            PG8_BAR; PG8_WAIT_L(0); PG8_MMA(1, 0, At, B0); PG8_BAR; PG8_SCHED;
            PG8_STAGE(PG8_SB(1, 1), b3 + hstep, voffB);
            PG8_WAIT_V(6); PG8_BAR; PG8_MMA(1, 1, At, B1); PG8_BAR;
            }
        }
        if constexpr (ALIGN_EPI) { if (wr == 0) PG8_BAR; }
        if constexpr (!Epi::AFTER_DRAIN) { E(acc, cur, wr, wc, fr, fq); S.done(cur); }
        if (!has_next) break;
#pragma unroll
        for (int a = 0; a < 2; ++a)
#pragma unroll
            for (int b = 0; b < 2; ++b)
#pragma unroll
                for (int m = 0; m < 4; ++m)
#pragma unroll
                    for (int n = 0; n < 2; ++n) acc[a][b][m][n] = (f32x4){0.f, 0.f, 0.f, 0.f};
        cur = nxt; cA = nA; cB = nB; ++ui;
        if constexpr (ALIGN_EPI) { if (wr == 1) PG8_BAR; }
    }
    PG8_WAIT_V(0);
    if constexpr (!ALIGN_EPI) { if (wr == 0) PG8_BAR; }
    PG8_BAR;
    if constexpr (Epi::AFTER_DRAIN) { E.fused(acc, cur, wr, wc, fr, fq, lds, wid, lane); S.done(cur); }
#undef PG8_SA
#undef PG8_SB
#undef PG8_STAGE
#undef PG8_LDA
#undef PG8_LDB
#undef PG8_MMA
#undef PG8_WAIT_V
#undef PG8_WAIT_L
#undef PG8_BAR
#undef PG8_SCHED
}
}
namespace fa {
using bf16=__hip_bfloat16;
using bf16x8=__attribute__((ext_vector_type(8)))short;
using s16x4=__attribute__((ext_vector_type(4)))short;
using f32x16=__attribute__((ext_vector_type(16)))float;
using f32x4=__attribute__((ext_vector_type(4)))float;
using u32x4=__attribute__((ext_vector_type(4)))unsigned;
constexpr int D=64;
constexpr int NW=8,QBLK=32,QB=QBLK*NW,KVBLK=64;
__device__ __forceinline__ int crow(int r,int hi){return (r&3)+8*(r>>2)+4*hi;}
#define SBAR() __builtin_amdgcn_sched_barrier(0)
__device__ __forceinline__ void cmask(f32x16&p0,f32x16&p1,int jb,int qrel,int hi){
  const float NEG=-INFINITY; int kb=64*jb+4*hi;
  #pragma unroll
  for(int r=0;r<16;++r){int kv=kb+(r&3)+8*(r>>2); if(kv>qrel)p0[r]=NEG; if(kv+32>qrel)p1[r]=NEG;}
}
constexpr int NSLOT=3, SLOTB=8192;
constexpr int LDS_K=0, LDS_V=NSLOT*SLOTB, LDS_WS=2*NSLOT*SLOTB, LDS_OST=LDS_WS+NW*64*4, LDS_OFF=LDS_OST+NW*4096, LDS_CL=LDS_OFF+256, LDS_BYTES=LDS_CL+65536;
constexpr float C2=0.125f*1.4426950408889634f;
__device__ __forceinline__ void glds16(const void*gsrc,unsigned lds_dst){unsigned keep;
  asm volatile("s_mov_b32 %0, m0\n\ts_mov_b32 m0, %2\n\ts_nop 0\n\tglobal_load_lds_dwordx4 %1, off\n\ts_mov_b32 m0, %0":"=&s"(keep):"v"(gsrc),"s"(lds_dst):"memory");}
__device__ __forceinline__ float max3f(float a,float b,float c){float r;asm("v_max3_f32 %0, %1, %2, %3":"=v"(r):"v"(a),"v"(b),"v"(c));return r;}
__device__ __forceinline__ float max2f(float a,float b){float r;asm("v_max_f32_e32 %0, %1, %2":"=v"(r):"v"(a),"v"(b));return r;}
__device__ __forceinline__ float fadd_s(float a,float b){float r;asm("v_add_f32_e32 %0, %1, %2":"=v"(r):"v"(a),"v"(b));return r;}
__device__ __forceinline__ float fsub_s(float a,float b){float r;asm("v_sub_f32_e32 %0, %1, %2":"=v"(r):"v"(a),"v"(b));return r;}
typedef float f32x2_t __attribute__((ext_vector_type(2))); typedef __bf16 bf16x2_t __attribute__((ext_vector_type(2)));
__device__ __forceinline__ unsigned cvtpk_s(float lo,float hi){f32x2_t v={lo,hi};bf16x2_t b=__builtin_convertvector(v,bf16x2_t);return __builtin_bit_cast(unsigned,b);}
#define WAIT_BAR(N) asm volatile("s_waitcnt vmcnt(" #N ") lgkmcnt(0)\n\ts_barrier":::"memory")
typedef __attribute__((address_space(3))) const char* lds_cptr;
typedef short v4i16_t __attribute__((ext_vector_type(4)));
__device__ __forceinline__ void qkt(f32x16&p0,f32x16&p1,lds_cptr Kslot,const bf16x8*qr,int r32,int hi){
  lds_cptr kb=Kslot+hi*1024+r32*16;
  #pragma unroll
  for(int d0=0;d0<4;++d0){
    const bf16x8 b0=*(const __attribute__((address_space(3))) bf16x8*)(kb+d0*2048);
    const bf16x8 b1=*(const __attribute__((address_space(3))) bf16x8*)(kb+d0*2048+512);
    p0=__builtin_amdgcn_mfma_f32_32x32x16_bf16(b0,qr[d0],p0,0,0,0);p1=__builtin_amdgcn_mfma_f32_32x32x16_bf16(b1,qr[d0],p1,0,0,0);}
}
__device__ __forceinline__ void kload8(bf16x8*kf,lds_cptr kp){
  kf[0]=*(const __attribute__((address_space(3))) bf16x8*)(kp);      kf[1]=*(const __attribute__((address_space(3))) bf16x8*)(kp+512);
  kf[2]=*(const __attribute__((address_space(3))) bf16x8*)(kp+2048); kf[3]=*(const __attribute__((address_space(3))) bf16x8*)(kp+2560);
  kf[4]=*(const __attribute__((address_space(3))) bf16x8*)(kp+4096); kf[5]=*(const __attribute__((address_space(3))) bf16x8*)(kp+4608);
  kf[6]=*(const __attribute__((address_space(3))) bf16x8*)(kp+6144); kf[7]=*(const __attribute__((address_space(3))) bf16x8*)(kp+6656);
}
__device__ __forceinline__ void kload2(bf16x8*kf,lds_cptr kp,int j){ kf[2*j]=*(const __attribute__((address_space(3))) bf16x8*)(kp+j*2048); kf[2*j+1]=*(const __attribute__((address_space(3))) bf16x8*)(kp+j*2048+512); }
__device__ __forceinline__ s16x4 vtr(lds_cptr p){ return __builtin_bit_cast(s16x4,__builtin_amdgcn_ds_read_tr16_b64_v4i16((__attribute__((address_space(3))) v4i16_t*)p)); }
__device__ __forceinline__ float rowmax(const f32x16&p0,const f32x16&p1){
  float a=max3f(p0[0],p0[1],p1[0]),b=max3f(p0[2],p0[3],p1[1]);a=max3f(a,p1[2],p1[3]);
  #pragma unroll
  for(int r=4;r<16;r+=4){a=max3f(a,p0[r],p0[r+1]);b=max3f(b,p0[r+2],p0[r+3]);a=max3f(a,p1[r],p1[r+1]);b=max3f(b,p1[r+2],p1[r+3]);}
  const float m=max2f(a,b);
  auto rr=__builtin_amdgcn_permlane32_swap(__float_as_uint(m),__float_as_uint(m),false,false);
  return max2f(__uint_as_float(rr[0]),__uint_as_float(rr[1]));
}
__device__ __forceinline__ void pv(f32x16*o,int vb,bf16x8 pa0,bf16x8 pa1,bf16x8 pa2,bf16x8 pa3){
  #pragma unroll
  for(int d0=0;d0<2;++d0){s16x4 lo[4],hi[4];
    #pragma unroll
    for(int ks=0;ks<4;++ks){
      asm volatile("ds_read_b64_tr_b16 %0,%1 offset:%c2":"=&v"(lo[ks]):"v"(vb),"i"(d0*4096+ks*1024):"memory");
      asm volatile("ds_read_b64_tr_b16 %0,%1 offset:%c2":"=&v"(hi[ks]):"v"(vb),"i"(d0*4096+ks*1024+512):"memory");}
    asm volatile("s_waitcnt lgkmcnt(0)":::"memory");SBAR();
    #define PK(k) (bf16x8){lo[k][0],lo[k][1],lo[k][2],lo[k][3],hi[k][0],hi[k][1],hi[k][2],hi[k][3]}
    o[d0]=__builtin_amdgcn_mfma_f32_32x32x16_bf16(pa0,PK(0),o[d0],0,0,0);
    o[d0]=__builtin_amdgcn_mfma_f32_32x32x16_bf16(pa1,PK(1),o[d0],0,0,0);
    o[d0]=__builtin_amdgcn_mfma_f32_32x32x16_bf16(pa2,PK(2),o[d0],0,0,0);
    o[d0]=__builtin_amdgcn_mfma_f32_32x32x16_bf16(pa3,PK(3),o[d0],0,0,0);
    #undef PK
  }
}
__device__ __forceinline__ float bfbits2f(unsigned short b){return __uint_as_float(((unsigned)b)<<16);}
__device__ __forceinline__ float silu_f(float z){return z/(1.f+__expf(-z));}

constexpr int SLOT_BYTES=36864;
__device__ __forceinline__ int slot_of(int part,int qb){ return part==1?63-qb:(part==2?111-qb:143-qb); }
template<int THRL,bool CAUSAL,bool BIAS,int QP,int KP,int OP,int PART>
__device__ __forceinline__ void attn_unit(int q0,int kbeg,int NT,const bf16*Qh,const bf16*__restrict__ Kh,const bf16*__restrict__ Vh,const bf16*Zh,bf16*Oh,const float*Cl,const float*Tb,const float*QNh,const float*KNh,const float*Dq,float thresh,
                                          int part,unsigned*flags,unsigned char*slot0,char*shm){
  int tid=threadIdx.x; asm volatile("":"+v"(tid)); const int lane=tid&63,r32=lane&31,hi=lane>>5; const int wid=__builtin_amdgcn_readfirstlane(tid>>6);
  const bf16*Qw=Qh+(long)(q0+wid*QBLK)*QP;
  const unsigned lds0=(unsigned)(uintptr_t)shm;
  float*wsf=(float*)(shm+LDS_WS)+wid*64;
  float cq=0.f,dq=0.f; int nfar=0;
  if constexpr(BIAS){
    float*offl=(float*)(shm+LDS_OFF); float*cll=(float*)(shm+LDS_CL); const int bq=q0>>10; int*tminp=(int*)(shm+LDS_OFF)+32;
    if(tid<16){ float tb_[16];
      _Pragma("unroll") for(int i=0;i<16;++i)tb_[i]=Tb[i];
      double s=0.0; _Pragma("unroll") for(int i=0;i<16;++i)s+=(i>=tid&&i<bq)?(double)tb_[i]:0.0; offl[tid]=(float)(-s); }
    if(thresh>0.f){
      if(tid>=64&&tid<128){ const int qb=q0>>8, l_=tid-64; float kv=(l_<=qb)?KNh[l_]:0.f; const float qn_=QNh[qb], dn_=QNh[1024+qb];
        _Pragma("unroll") for(int o_=1;o_<64;o_<<=1)kv=fmaxf(kv,__shfl_xor(kv,o_));
        if(l_==0){ offl[20]=thresh+sqrtf(qn_*kv)-dn_+1.f; *tminp=q0>>6; } }
      __syncthreads();
      const float lim=offl[20]; const int nt0=q0>>6;
      if(tid<nt0){ const int kl=64*tid+63; const float b_=Cl[q0]-(Cl[kl]+offl[kl>>10]); if(!(b_<-lim))atomicMin(tminp,tid); }
      __syncthreads();
      const int tf=__builtin_amdgcn_readfirstlane(*tminp)&~1; kbeg=64*tf; NT=(q0+256-kbeg)>>6;
    }
    if(flags){ const int NTf=(q0+256)>>6, tf=kbeg>>6, qb=q0>>8;
      if constexpr(PART==1){ const int hiT=NTf-64*part; int lo=hiT-64; lo=lo<0?0:lo; lo=lo<tf?tf:lo; if(lo>=hiT){ __syncthreads(); return; } if(hiT-lo<4)lo=hiT-4; kbeg=64*lo; NT=hiT-lo; }
      else { for(int p_=1;p_<=(qb>>4);++p_) if(tf<NTf-64*p_) nfar=p_; const int lo=(tf<NTf-64)?(NTf-64):tf; kbeg=64*lo; NT=NTf-lo; } }
    __syncthreads();
    { const float base_=Cl[q0];
      for(int i=tid;i<NT*64;i+=512){ const int k=kbeg+i; const float x_=base_-(Cl[k]+offl[k>>10]); const unsigned hb_=cvtpk_s(x_,0.f)&0xffffu; const float hf_=__uint_as_float(hb_<<16);
        ((unsigned*)cll)[i]=hb_|(cvtpk_s(x_-hf_,0.f)<<16); }
      if(tid==0)offl[24]=0.f;
      cq=Cl[q0+wid*QBLK+r32]-base_; dq=Dq[q0+wid*QBLK+r32]; }
    __syncthreads();
  }
  const bf16*ksrc=Kh+(long)(kbeg+lane)*KP+wid*8;
  const bf16*vsrc=Vh+(long)(kbeg+16*(wid&3)+(lane>>2))*KP+(wid>>2)*32+(lane&3)*8;
  const unsigned kdst=lds0+LDS_K+wid*1024, vdst=lds0+LDS_V+wid*1024;
  #define DMA_K(t,slot) glds16(ksrc+(long)(t)*KVBLK*KP,(unsigned)__builtin_amdgcn_readfirstlane(kdst+(slot)))
  #define DMA_V(t,slot) glds16(vsrc+(long)(t)*KVBLK*KP,(unsigned)__builtin_amdgcn_readfirstlane(vdst+(slot)))
  const int vb0=(int)(lds0+LDS_V)+((lane>>4)&1)*32+(lane&3)*8+(4*hi+((lane&15)>>2))*64;
  bf16x8 kf[8];
  const lds_cptr shm3=(lds_cptr)shm; const lds_cptr kp0=shm3+LDS_K+hi*1024+r32*16; const lds_cptr vp0=shm3+LDS_V+((lane>>4)&1)*32+(lane&3)*8+(4*hi+((lane&15)>>2))*64;
  const lds_cptr clz=shm3+LDS_OFF+96; const lds_cptr clp0=shm3+LDS_CL+r32*4; const unsigned ONESh=hi?0u:0x3F803F80u; unsigned cqmw=0u;
  DMA_K(0,0);DMA_V(0,0);DMA_K(1,SLOTB);
  bf16x8 qr[4];
  #pragma unroll
  for(int d0=0;d0<4;++d0)qr[d0]=*reinterpret_cast<const bf16x8*>(&Qw[(long)r32*QP+d0*16+hi*8]);
  float mhat=dq,l_reg=0.f;f32x16 o[2];o[0]=f32x16{};o[1]=f32x16{};
  const int qrel=wid*QBLK+r32;
  #define CMASK(P0,P1,t) do{ if constexpr(CAUSAL){int jb_=(t)-(NT-4); if(jb_>=0)cmask(P0,P1,jb_,qrel,hi);} }while(0)
  #define UPD_BB() do{ if constexpr(BIAS){ const float x_=cq-mhat; const unsigned hb_=cvtpk_s(x_,0.f)&0xffffu; const float hf_=__uint_as_float(hb_<<16); cqmw=hi?0u:(hb_|(cvtpk_s(x_-hf_,0.f)<<16)); } }while(0)
  #define CINIT(C0,C1,t) do{ \
    if constexpr(BIAS){   \
      const bf16x8 a0_=__builtin_bit_cast(bf16x8,(u32x4){wn0,ONESh,0u,0u}), a1_=__builtin_bit_cast(bf16x8,(u32x4){wn1,ONESh,0u,0u}), bb_=__builtin_bit_cast(bf16x8,(u32x4){ONESh,cqmw,0u,0u}); \
      C0=__builtin_amdgcn_mfma_f32_32x32x16_bf16(a0_,bb_,f32x16{},0,0,0); C1=__builtin_amdgcn_mfma_f32_32x32x16_bf16(a1_,bb_,f32x16{},0,0,0); \
      { const lds_cptr p0_=hi?clz:(clp0+((t)+1)*256); wn0=*(const __attribute__((address_space(3))) unsigned*)p0_; wn1=*(const __attribute__((address_space(3))) unsigned*)(hi?clz:(p0_+128)); } } \
    else { const float cqm_=cq-mhat; _Pragma("unroll") for(int r_=0;r_<16;++r_){C0[r_]=cqm_;C1[r_]=cqm_;} \
      asm volatile("":"+v"(C0)); asm volatile("":"+v"(C1)); } }while(0)
  UPD_BB();
  unsigned wn0=0u,wn1=0u; if constexpr(BIAS){ wn0=*(const __attribute__((address_space(3))) unsigned*)(hi?clz:clp0); wn1=*(const __attribute__((address_space(3))) unsigned*)(hi?clz:(clp0+128)); }
  bool resc=false;
  #define START(P0,P1) do{ const float rm=rowmax(P0,P1); resc=false; \
    { const float dl=rm; mhat=fadd_s(mhat,dl); \
      _Pragma("unroll") for(int r=0;r<16;++r){P0[r]=fsub_s(P0[r],dl);P1[r]=fsub_s(P1[r],dl);} } \
    _Pragma("unroll") for(int r=0;r<16;++r)P0[r]=__builtin_amdgcn_exp2f(P0[r]); }while(0)
  #define RESC() do{ if(resc){ asm volatile("s_waitcnt lgkmcnt(0)":::"memory"); \
      _Pragma("unroll") for(int d_=0;d_<2;++d_) _Pragma("unroll") for(int r=0;r<16;++r)o[d_][r]*=wsf[crow(r,hi)]; } }while(0)
  f32x16 pA0,pA1,pB0,pB1;
  int sl_prev=0,sl_cur=0,sl_next=SLOTB;
  #define ROT() do{sl_prev=sl_cur;sl_cur=sl_next;sl_next=(sl_next==(NSLOT-1)*SLOTB)?0:sl_next+SLOTB;}while(0)
  DMA_K(2,2*SLOTB);
  WAIT_BAR(3);
  CINIT(pA0,pA1,0);
  qkt(pA0,pA1,shm3+LDS_K,qr,r32,hi);asm volatile("s_nop 15\n\ts_nop 7":"+v"(pA0),"+v"(pA1));CMASK(pA0,pA1,0);
  const float skipt=(BIAS&&thresh>0.f)?-thresh:-INFINITY; bool alive=true;
  #define DECIDE(C0,C1,RM,AL) do{ AL=!(__all((RM)<skipt)!=0); \
    if(AL){ if(__any((RM)>(float)THRL)){ const float dl_=__builtin_fmaxf((RM),0.f); mhat+=dl_; UPD_BB(); _Pragma("unroll") for(int r=0;r<16;++r){C0[r]-=dl_;C1[r]-=dl_;} } \
      _Pragma("unroll") for(int r=0;r<16;++r){C0[r]=__builtin_amdgcn_exp2f(C0[r]);C1[r]=__builtin_amdgcn_exp2f(C1[r]);} } \
    else { _Pragma("unroll") for(int r=0;r<16;++r){C0[r]=0.f;C1[r]=0.f;} } }while(0)
  if constexpr(BIAS){ const float rm0=rowmax(pA0,pA1); DECIDE(pA0,pA1,rm0,alive); }
  else { START(pA0,pA1);
    _Pragma("unroll") for(int r=0;r<16;++r)pA1[r]=__builtin_amdgcn_exp2f(pA1[r]); }
  WAIT_BAR(0);
  DMA_K(3,0);DMA_V(1,SLOTB);
  ROT();
  kload8(kf,kp0+sl_cur);
  WAIT_BAR(2);
  s16x4 vlo[8],vhi[8]; u32x4 pw0,pw1,pw2,pw3;
  #define PKW(P,B) cvtpk_s(P[B],P[B+1])
  #define PAF(k) __builtin_bit_cast(bf16x8,pw##k)
  #define VFR(i) (bf16x8){vlo[i][0],vlo[i][1],vlo[i][2],vlo[i][3],vhi[i][0],vhi[i][1],vhi[i][2],vhi[i][3]}
  #define PIN(x) asm volatile("":"+v"(x))
  #define MX3(a,b,c) __builtin_fmaxf(__builtin_fmaxf((a),(b)),(c))
  #define GAPA(MF,A0,A1,A2,A3,W0,W1,PW) do{ MF; sacc+=A0; sacc+=A1; sacc+=A2; sacc+=A3; PIN(sacc); W0; W1; PIN(PW); SBAR(); }while(0)
  #define EX(v) __builtin_amdgcn_exp2f(v)
  #define GAPB(MF,X,B) do{ MF; X[B]=EX(X[B]); X[B+1]=EX(X[B+1]); X[B+2]=EX(X[B+2]); X[B+3]=EX(X[B+3]); PIN(X); SBAR(); }while(0)
  #define VRD(i) do{ vlo[i]=vtr(vp_+(((i)>>2)*4096+((i)&3)*1024)); vhi[i]=vtr(vp_+(((i)>>2)*4096+((i)&3)*1024+512)); }while(0)
  #define KRD(G,j) do{ if(G){ kload2(kf,kp0+sl_next,j); SBAR(); } }while(0)
  #define STEP(C0,C1,P0,P1,t,GK,GV,GL) do{ SBAR(); \
    CINIT(C0,C1,t); SBAR(); \
    const lds_cptr vp_=vp0+sl_prev; \
    VRD(0); SBAR(); float sacc=(P0[0]+P0[1]); \
    GAPA(C0=__builtin_amdgcn_mfma_f32_32x32x16_bf16(kf[0],qr[0],C0,0,0,0), P0[2],P0[3],P0[4],P0[5],     pw0[0]=PKW(P0,0), pw0[1]=PKW(P0,2), pw0); \
    VRD(4); SBAR(); GAPA(C1=__builtin_amdgcn_mfma_f32_32x32x16_bf16(kf[1],qr[0],C1,0,0,0), P0[6],P0[7],P0[8],P0[9],     pw0[2]=PKW(P0,4), pw0[3]=PKW(P0,6), pw0); \
    VRD(1); SBAR(); GAPA(C0=__builtin_amdgcn_mfma_f32_32x32x16_bf16(kf[2],qr[1],C0,0,0,0),   P0[10],P0[11],P0[12],P0[13], pw1[0]=PKW(P0,8), pw1[1]=PKW(P0,10), pw1); \
    VRD(5); SBAR(); GAPA(C1=__builtin_amdgcn_mfma_f32_32x32x16_bf16(kf[3],qr[1],C1,0,0,0),   P0[14],P0[15],P1[0],P1[1],   pw1[2]=PKW(P0,12),pw1[3]=PKW(P0,14), pw1); \
    VRD(2); SBAR(); GAPA(C0=__builtin_amdgcn_mfma_f32_32x32x16_bf16(kf[4],qr[2],C0,0,0,0),   P1[2],P1[3],P1[4],P1[5],     pw2[0]=PKW(P1,0), pw2[1]=PKW(P1,2), pw2); \
    VRD(6); SBAR(); GAPA(C1=__builtin_amdgcn_mfma_f32_32x32x16_bf16(kf[5],qr[2],C1,0,0,0),   P1[6],P1[7],P1[8],P1[9],     pw2[2]=PKW(P1,4), pw2[3]=PKW(P1,6), pw2); \
    VRD(3); SBAR(); GAPA(C0=__builtin_amdgcn_mfma_f32_32x32x16_bf16(kf[6],qr[3],C0,0,0,0),   P1[10],P1[11],P1[12],P1[13], pw3[0]=PKW(P1,8), pw3[1]=PKW(P1,10), pw3); \
    VRD(7); SBAR(); GAPA(C1=__builtin_amdgcn_mfma_f32_32x32x16_bf16(kf[7],qr[3],C1,0,0,0),   P1[14],P1[15],0.f,0.f,       pw3[2]=PKW(P1,12),pw3[3]=PKW(P1,14), pw3); \
    l_reg+=sacc; \
    if(GK){DMA_K((t)+3,sl_cur);} if(GV){DMA_V((t)+1,sl_next);} \
    CMASK(C0,C1,t); \
    { float a=MX3(C0[0],C0[1],C1[0]),b=MX3(C0[2],C0[3],C1[1]); a=MX3(a,C1[2],C1[3]); \
      _Pragma("unroll") for(int r=4;r<16;r+=4){a=MX3(a,C0[r],C0[r+1]);b=MX3(b,C0[r+2],C0[r+3]);a=MX3(a,C1[r],C1[r+1]);b=MX3(b,C1[r+2],C1[r+3]);} \
      float rm=__builtin_fmaxf(a,b); { auto rr=__builtin_amdgcn_permlane32_swap(__float_as_uint(rm),__float_as_uint(rm),false,false); rm=__builtin_fmaxf(__uint_as_float(rr[0]),__uint_as_float(rr[1])); } \
      resc=false; \
      if(__builtin_expect(__any(rm>(float)THRL),0)){ const float dl=__builtin_fmaxf(rm,0.f); mhat+=dl; UPD_BB(); \
        _Pragma("unroll") for(int r=0;r<16;++r){C0[r]-=dl;C1[r]-=dl;} \
        const float f=__builtin_amdgcn_exp2f(-dl); l_reg*=f; if(hi==0)wsf[r32]=f; resc=true; } } \
    SBAR(); \
    GAPB(o[0]=__builtin_amdgcn_mfma_f32_32x32x16_bf16(PAF(0),VFR(0),o[0],0,0,0), C0,0); \
    GAPB(o[1]=__builtin_amdgcn_mfma_f32_32x32x16_bf16(PAF(0),VFR(4),o[1],0,0,0), C0,4); \
    KRD(GL,0); GAPB(o[0]=__builtin_amdgcn_mfma_f32_32x32x16_bf16(PAF(1),VFR(1),o[0],0,0,0), C0,8); \
    KRD(GL,1); GAPB(o[1]=__builtin_amdgcn_mfma_f32_32x32x16_bf16(PAF(1),VFR(5),o[1],0,0,0), C0,12); \
    KRD(GL,2); GAPB(o[0]=__builtin_amdgcn_mfma_f32_32x32x16_bf16(PAF(2),VFR(2),o[0],0,0,0), C1,0); \
    KRD(GL,3); GAPB(o[1]=__builtin_amdgcn_mfma_f32_32x32x16_bf16(PAF(2),VFR(6),o[1],0,0,0), C1,4); \
    GAPB(o[0]=__builtin_amdgcn_mfma_f32_32x32x16_bf16(PAF(3),VFR(3),o[0],0,0,0), C1,8); \
    GAPB(o[1]=__builtin_amdgcn_mfma_f32_32x32x16_bf16(PAF(3),VFR(7),o[1],0,0,0), C1,12); \
    }while(0)
  int t=1;
  #undef CMASK
  #define CMASK(P0,P1,t) do{}while(0)
  if constexpr(BIAS){
    #define LIGHT(C0,C1,t,AL) do{ SBAR(); CINIT(C0,C1,t); SBAR(); \
      C0=__builtin_amdgcn_mfma_f32_32x32x16_bf16(kf[0],qr[0],C0,0,0,0); C1=__builtin_amdgcn_mfma_f32_32x32x16_bf16(kf[1],qr[0],C1,0,0,0); \
      C0=__builtin_amdgcn_mfma_f32_32x32x16_bf16(kf[2],qr[1],C0,0,0,0); C1=__builtin_amdgcn_mfma_f32_32x32x16_bf16(kf[3],qr[1],C1,0,0,0); \
      C0=__builtin_amdgcn_mfma_f32_32x32x16_bf16(kf[4],qr[2],C0,0,0,0); C1=__builtin_amdgcn_mfma_f32_32x32x16_bf16(kf[5],qr[2],C1,0,0,0); \
      C0=__builtin_amdgcn_mfma_f32_32x32x16_bf16(kf[6],qr[3],C0,0,0,0); C1=__builtin_amdgcn_mfma_f32_32x32x16_bf16(kf[7],qr[3],C1,0,0,0); SBAR(); \
      DMA_K((t)+3,sl_cur); DMA_V((t)+1,sl_next); \
      { float a=MX3(C0[0],C0[1],C1[0]),b=MX3(C0[2],C0[3],C1[1]); a=MX3(a,C1[2],C1[3]); \
        _Pragma("unroll") for(int r=4;r<16;r+=4){a=MX3(a,C0[r],C0[r+1]);b=MX3(b,C0[r+2],C0[r+3]);a=MX3(a,C1[r],C1[r+1]);b=MX3(b,C1[r+2],C1[r+3]);} \
        float rm=__builtin_fmaxf(a,b); { auto rr=__builtin_amdgcn_permlane32_swap(__float_as_uint(rm),__float_as_uint(rm),false,false); rm=__builtin_fmaxf(__uint_as_float(rr[0]),__uint_as_float(rr[1])); } \
        DECIDE(C0,C1,rm,AL); } \
      kload8(kf,kp0+sl_next); }while(0)
    while(!alive&&t+6<NT){
      LIGHT(pB0,pB1,t,alive); WAIT_BAR(2); ROT(); ++t;
      if(alive){ STEP(pA0,pA1,pB0,pB1,t,true,true,true); WAIT_BAR(2); RESC(); ROT(); ++t; break; }
      LIGHT(pA0,pA1,t,alive); WAIT_BAR(2); ROT(); ++t;
    }
    #undef LIGHT
  }
  for(;t+5<NT;t+=2){
    STEP(pB0,pB1,pA0,pA1,t,true,true,true);     WAIT_BAR(2); RESC(); ROT();
    STEP(pA0,pA1,pB0,pB1,t+1,true,true,true);   WAIT_BAR(2); RESC(); ROT();
  }
  #undef CMASK
  #define CMASK(P0,P1,t) do{ if constexpr(CAUSAL){int jb_=(t)-(NT-4); if(jb_>=0)cmask(P0,P1,jb_,qrel,hi);} }while(0)
  #define ENDW(tt) do{ if((tt)+3<NT){WAIT_BAR(2);} else if((tt)+2<NT){WAIT_BAR(1);} else {WAIT_BAR(0);} }while(0)
  for(;t+1<NT;t+=2){
    STEP(pB0,pB1,pA0,pA1,t,(t+3<NT),(t+1<NT),(t+1<NT));       ENDW(t);   RESC(); ROT();
    STEP(pA0,pA1,pB0,pB1,t+1,(t+4<NT),(t+2<NT),(t+2<NT));     ENDW(t+1); RESC(); ROT();
  }
  STEP(pB0,pB1,pA0,pA1,NT-1,false,false,false); RESC();
  { float sacc=pB0[0]+pB0[1]; _Pragma("unroll") for(int r=2;r<16;++r)sacc+=pB0[r]; _Pragma("unroll") for(int r=0;r<16;++r)sacc+=pB1[r]; l_reg+=sacc;
    pw0=(u32x4){PKW(pB0,0),PKW(pB0,2),PKW(pB0,4),PKW(pB0,6)};pw1=(u32x4){PKW(pB0,8),PKW(pB0,10),PKW(pB0,12),PKW(pB0,14)};pw2=(u32x4){PKW(pB1,0),PKW(pB1,2),PKW(pB1,4),PKW(pB1,6)};pw3=(u32x4){PKW(pB1,8),PKW(pB1,10),PKW(pB1,12),PKW(pB1,14)};
    SBAR(); pv(o,vb0+sl_cur,PAF(0),PAF(1),PAF(2),PAF(3)); }
  #undef PKW
  #undef PAF
  #undef VFR
  #undef PIN
  #undef MX3
  #undef GAPA
  #undef GAPB
  #undef EX
  #undef VRD
  #undef KRD
  #undef STEP
  #undef ENDW
  #undef CINIT
  #undef UPD_BB
  #undef DECIDE
  {auto rr=__builtin_amdgcn_permlane32_swap(__float_as_uint(l_reg),__float_as_uint(l_reg),false,false);l_reg=__uint_as_float(rr[0])+__uint_as_float(rr[1]);}
  if constexpr(BIAS&&PART==0){
    for(int p_=1;p_<=nfar;++p_){ const int e_=slot_of(p_,q0>>8);
      if(tid==0){ unsigned sp_=0; while(__hip_atomic_load(&flags[e_],__ATOMIC_RELAXED,__HIP_MEMORY_SCOPE_AGENT)==0u){ __builtin_amdgcn_s_sleep(2); if(++sp_>(1u<<22))break; } }
      __syncthreads();
      __builtin_amdgcn_fence(__ATOMIC_ACQUIRE,"agent");
      const unsigned char*slot=slot0+(size_t)e_*SLOT_BYTES; const float*ml=(const float*)(slot+32768)+wid*64;
      const float mi=ml[r32],li=ml[32+r32]; const float M_=fmaxf(mhat,mi); const float fo=__builtin_amdgcn_exp2f(mhat-M_),g_=li*__builtin_amdgcn_exp2f(mi-M_);
      l_reg=l_reg*fo+g_; mhat=M_;
      u32x4 ov[4];
      #pragma unroll
      for(int j=0;j<4;++j)ov[j]=((const u32x4*)slot)[(wid*4+j)*64+lane];
      if(hi==0){wsf[r32]=fo;wsf[32+r32]=g_;} asm volatile("s_waitcnt lgkmcnt(0)":::"memory");
      #pragma unroll
      for(int d0=0;d0<2;++d0)
        #pragma unroll
        for(int r=0;r<16;++r){ const unsigned w_=ov[d0*2+(r>>3)][(r&7)>>1]; const float oi=(r&1)?__uint_as_float(w_&0xffff0000u):__uint_as_float(w_<<16);
          o[d0][r]=o[d0][r]*wsf[crow(r,hi)]+wsf[32+crow(r,hi)]*oi; }
      asm volatile("s_waitcnt lgkmcnt(0)":::"memory");
    }
  }
  if(hi==0)wsf[32+r32]=l_reg;asm volatile("s_waitcnt lgkmcnt(0)":::"memory");
  float rli[16];
  #pragma unroll
  for(int r=0;r<16;++r)rli[r]=__builtin_amdgcn_rcpf(wsf[32+crow(r,hi)]);
  if constexpr(PART==1){
    const int e_=slot_of(part,q0>>8); unsigned char*slot=slot0+(size_t)e_*SLOT_BYTES;
    #pragma unroll
    for(int j=0;j<4;++j){ const int d0=j>>1,rb=8*(j&1); u32x4 w;
      #pragma unroll
      for(int i=0;i<4;++i)w[i]=cvtpk_s(o[d0][rb+2*i]*rli[rb+2*i],o[d0][rb+2*i+1]*rli[rb+2*i+1]);
      ((u32x4*)slot)[(wid*4+j)*64+lane]=w; }
    if(hi==0){ float*ml=(float*)(slot+32768)+wid*64; ml[r32]=mhat; ml[32+r32]=l_reg; }
    asm volatile("s_waitcnt vmcnt(0) lgkmcnt(0)":::"memory");
    __syncthreads();
    if(tid==0){ __builtin_amdgcn_fence(__ATOMIC_RELEASE,"agent"); asm volatile("s_waitcnt vmcnt(0)":::"memory"); __hip_atomic_store(&flags[e_],1u,__ATOMIC_RELAXED,__HIP_MEMORY_SCOPE_AGENT); }
    asm volatile("s_waitcnt lgkmcnt(0)\n\ts_barrier":::"memory");
    return;
  }
  bf16*Ow=Oh+(long)(q0+wid*QBLK)*OP; const bf16*Zw=Zh+(long)(q0+wid*QBLK)*QP;
  { bf16*stg=(bf16*)(shm+LDS_OST)+wid*2048;
    #pragma unroll
    for(int r=0;r<16;++r){const int orow=crow(r,hi);
      #pragma unroll
      for(int d0=0;d0<2;++d0)stg[orow*64+d0*32+r32]=__float2bfloat16(o[d0][r]*rli[r]);}
    asm volatile("s_waitcnt lgkmcnt(0)":::"memory");
    #pragma unroll
    for(int i=0;i<4;++i){const int row=i*8+(lane>>3),ch=lane&7; const u32x4 v=*(const u32x4*)(stg+row*64+ch*8); const u32x4 z=*(const u32x4*)(Zw+(long)row*QP+ch*8);
      u32x4 w;
      #pragma unroll
      for(int e=0;e<4;++e){ const float a0=__uint_as_float(v[e]<<16),a1=__uint_as_float(v[e]&0xffff0000u); const float z0=__uint_as_float(z[e]<<16),z1=__uint_as_float(z[e]&0xffff0000u);
        w[e]=cvtpk_s(a0*silu_f(z0),a1*silu_f(z1)); }
      asm volatile("global_store_dwordx4 %0, %1, off sc1\n\ts_nop 1"::"v"(Ow+(long)row*OP+ch*8),"v"(w):"memory"); } }
  asm volatile("s_waitcnt lgkmcnt(0)\n\ts_barrier":::"memory");
  #undef DMA_K
  #undef DMA_V
  #undef CMASK
  #undef START
  #undef RESC
  #undef ROT
}
#undef SBAR
#undef WAIT_BAR
}
#define LAS __attribute__((address_space(3)))
typedef unsigned short u16;
typedef float f32x4g __attribute__((ext_vector_type(4)));
typedef unsigned u32x4g __attribute__((ext_vector_type(4)));
typedef unsigned u32x2g __attribute__((ext_vector_type(2)));
typedef short bf16x8g __attribute__((ext_vector_type(8)));

constexpr int S_ = 16384, DM_ = 1024, DEPTH_ = 4, NMEM = 256;
constexpr int DIN_ORIG = 3592, NIN = 3584;
constexpr int PP = NIN;
constexpr int C_FQ = 0, C_FK = 512, C_FV = 1024, C_FZ = 1536, C_RQ = 2048, C_RK = 2304, C_RV = 2560, C_RZ = 2816, C_MQ = 3072, C_MZ = 3328;
constexpr float EPS_ = 1e-6f;
constexpr float LOG2E = 1.4426950408889634f;
constexpr int NTHR = 512;
#ifndef PRUNE_THRESH
#define PRUNE_THRESH 54.0f
#endif

#ifndef FOX_SPLIT
#define FOX_SPLIT 0
#endif
constexpr size_t MiB = 1u << 20;
constexpr size_t WS_BT0 = 1 * MiB;
constexpr size_t WS_BT1 = WS_BT0 + (size_t)(NIN + 2048) * 1024 * 2;
constexpr size_t BT_STRIDE = (size_t)NIN * 1024 * 2;
constexpr size_t WS_WOT = WS_BT1 + 3 * BT_STRIDE;
constexpr size_t WS_WF = WS_WOT + 4 * (size_t)1024 * 1024 * 2;
constexpr size_t WS_ROPE = WS_WF + 4 * 8 * 1024 * 4;
constexpr size_t WS_H = WS_ROPE + (size_t)S_ * 32 * 8;
constexpr size_t WS_P = WS_H + (size_t)(S_ + 1024) * 1024 * 2;
constexpr size_t WS_MKV = WS_P + (size_t)S_ * PP * 2;
constexpr size_t WS_LF = WS_MKV + 4 * (size_t)256 * 512 * 2;
constexpr size_t WS_CL = WS_LF + (size_t)S_ * 8 * 4;
constexpr size_t WS_TB = WS_CL + (size_t)S_ * 8 * 4;
constexpr size_t WS_KVST = WS_TB + 4096;
constexpr size_t WS_QN = WS_KVST + (size_t)4 * 128 * 4096 * 4;
constexpr size_t WS_PART = WS_QN + 8192;
constexpr size_t WS_XB = WS_PART + (FOX_SPLIT ? (size_t)768 * fa::SLOT_BYTES : 0);
constexpr size_t WS_DQ = WS_XB + (size_t)S_ * 1024 * 2;
constexpr size_t WS_END = WS_DQ + (size_t)8 * S_ * 4;
static_assert(WS_END <= 256 * MiB, "workspace map must fit 256 MiB");
static_assert((size_t)S_ * 1024 * 4 <= (size_t)S_ * PP * 2, "O overlays P");

constexpr int LDS_BYTES = 152 * 1024;
static_assert(fa::LDS_BYTES <= LDS_BYTES - 64 && pg8::STAGE_BYTES <= LDS_BYTES - 64, "LDS");

__device__ __forceinline__ void st16_wt(void* ptr, u32x4g v) { asm volatile("global_store_dwordx4 %0, %1, off sc1\n\ts_nop 1" :: "v"(ptr), "v"(v) : "memory"); }
typedef float f32x2h __attribute__((ext_vector_type(2))); typedef __bf16 bf16x2h __attribute__((ext_vector_type(2)));
__device__ __forceinline__ unsigned pk2(float lo, float hi) { const f32x2h v = {lo, hi}; return __builtin_bit_cast(unsigned, __builtin_convertvector(v, bf16x2h)); }
__device__ __forceinline__ unsigned f2bf(float f) { return pk2(f, 0.f) & 0xffffu; }
__device__ __forceinline__ float bf2f(u16 b) { return __uint_as_float(((unsigned)b) << 16); }
template <int CTRL> __device__ __forceinline__ float dppf(float v) { return __builtin_bit_cast(float, __builtin_amdgcn_update_dpp(0, __builtin_bit_cast(int, v), CTRL, 0xf, 0xf, true)); }
__device__ __forceinline__ float wave_sum(float v) {
    v += dppf<0xB1>(v);
    v += dppf<0x4E>(v);
    v += dppf<0x141>(v);
    v += dppf<0x140>(v);
    const int b = __builtin_bit_cast(int, v);
    const float s0 = __builtin_bit_cast(float, __builtin_amdgcn_readlane(b, 0)), s1 = __builtin_bit_cast(float, __builtin_amdgcn_readlane(b, 16));
    const float s2 = __builtin_bit_cast(float, __builtin_amdgcn_readlane(b, 32)), s3 = __builtin_bit_cast(float, __builtin_amdgcn_readlane(b, 48));
    return (s0 + s1) + (s2 + s3);
}

struct Params {
    const float* x; const float* mem; const float* w_in; const float* b_f; const float* w_out; const float* w_mkv; const float* g_pre; const float* g_post; const float* g_mem;
    float* out; unsigned char* ws; int ph_lo, ph_hi;
};

__device__ __forceinline__ unsigned char* wsbase(const Params& p) { unsigned char* w = p.ws; asm volatile("" : "+s"(w)); return w; }

__device__ __forceinline__ int win_col(int n) {
    if (n < 2048) return n;
    if (n < 2560) { const int hd = (n - 2048) >> 6, c = (n - 2048) & 63; return 2056 + hd * 64 + (c >> 1) + 32 * (c & 1); }
    return n + 8;
}
template <bool WIN>
__device__ __forceinline__ void transpose_load(const float* W, int ldw, int k0, int n0, LAS float* scr, int tid) {
    const int nn = tid & 63, kk = tid >> 6; const int col = WIN ? win_col(n0 + nn) : (n0 + nn);
#pragma unroll
    for (int i = 0; i < 8; ++i) scr[(kk + 8 * i) * 65 + nn] = W[(size_t)(k0 + kk + 8 * i) * ldw + col];
}
__device__ __forceinline__ void transpose_store(u16* WT, int k0, int n0, const LAS float* scr, int tid) {
    const int nn = tid >> 3, c = tid & 7; const LAS float* s = scr + (8 * c) * 65 + nn;
    u32x4g o; o.x = pk2(s[0], s[65]); o.y = pk2(s[2 * 65], s[3 * 65]); o.z = pk2(s[4 * 65], s[5 * 65]); o.w = pk2(s[6 * 65], s[7 * 65]);
    *(u32x4g*)(WT + (size_t)(n0 + nn) * 1024 + k0 + 8 * c) = o;
}
struct TTile { const float* W; u16* WT; int ldw, k0, n0; bool win; };
__device__ __forceinline__ TTile ttile(const Params& p, int it) {
    constexpr int T_IN = 56 * 16, T_OUT = 16 * 16, T_MKV = 8 * 16; unsigned char* ws = wsbase(p); TTile t;
    if (it < 4 * T_IN) { const int l = it / T_IN, r = it % T_IN; t.W = p.w_in + (size_t)l * 1024 * DIN_ORIG; t.ldw = DIN_ORIG; t.WT = (u16*)(ws + (l == 0 ? WS_BT0 : WS_BT1 + (size_t)(l - 1) * BT_STRIDE)); t.n0 = (r >> 4) * 64; t.k0 = (r & 15) * 64; t.win = true; }
    else if (it < 4 * (T_IN + T_OUT)) { const int q = it - 4 * T_IN, l = q / T_OUT, r = q % T_OUT; t.W = p.w_out + (size_t)l * 1024 * 1024; t.ldw = 1024; t.WT = (u16*)(ws + WS_WOT) + (size_t)l * 1024 * 1024; t.n0 = (r >> 4) * 64; t.k0 = (r & 15) * 64; t.win = false; }
    else { const int q = it - 4 * (T_IN + T_OUT), l = q / T_MKV, r = q % T_MKV; t.W = p.w_mkv + (size_t)l * 1024 * 512; t.ldw = 512; t.WT = (u16*)(ws + WS_BT0) + (size_t)(NIN + 512 * l) * 1024; t.n0 = (r >> 4) * 64; t.k0 = (r & 15) * 64; t.win = false; }
    return t;
}

__device__ __forceinline__ void transpose_range(const Params& p, int first, int count, int idx, int nw, LAS float* scr, int tid) {
    for (int j0 = idx * 4; j0 < count; j0 += nw * 4) {
#pragma unroll
        for (int q = 0; q < 4; ++q) { if (j0 + q < count) { const TTile t = ttile(p, first + j0 + q); if (t.win) transpose_load<true>(t.W, t.ldw, t.k0, t.n0, scr + q * 4224, tid); else transpose_load<false>(t.W, t.ldw, t.k0, t.n0, scr + q * 4224, tid); } }
        __syncthreads();
#pragma unroll
        for (int q = 0; q < 4; ++q) { if (j0 + q < count) { const TTile t = ttile(p, first + j0 + q); transpose_store(t.WT, t.k0, t.n0, scr + q * 4224, tid); } }
        __syncthreads();
    }
}

template <int XIN, int XOUT, bool FG>
__device__ __forceinline__ void norm_phase(const Params& p, int L, LAS float* wfl, int tid) {
    asm volatile("" : "+v"(tid));
    constexpr bool HAS_O = XOUT != 0, HAS_H = XOUT != 2;
    unsigned char* ws = wsbase(p); const int lane = tid & 63, wid = tid >> 6;
    const float* xprev = p.x; u16* XB = (u16*)(ws + WS_XB);
    const u16* O = (const u16*)(ws + WS_P);
    u16* H = (u16*)(ws + WS_H); float* LF = (float*)(ws + WS_LF);
    if constexpr (HAS_H && FG) { const float* wf = p.w_in + (size_t)L * 1024 * DIN_ORIG + 2048;
        for (int i = tid; i < 8 * 1024; i += NTHR) { const int g = i & 7, k = i >> 3; wfl[g * 1024 + k] = wf[(size_t)k * DIN_ORIG + g]; }
        __syncthreads(); }
    f32x4g gpo[4], gpr[4];
#pragma unroll
    for (int j = 0; j < 4; ++j) { gpo[j] = HAS_O ? *((const f32x4g*)(p.g_post + (size_t)(L - 1) * 1024) + lane + 64 * j) : (f32x4g){0.f, 0.f, 0.f, 0.f};
        gpr[j] = HAS_H ? *((const f32x4g*)(p.g_pre + (size_t)L * 1024) + lane + 64 * j) : (f32x4g){0.f, 0.f, 0.f, 0.f}; }
    float bfv = 0.f; if (HAS_H && FG && lane < 8) bfv = p.b_f[L * 8 + lane];
    const int rstride = gridDim.x * 8;
    for (int row0 = blockIdx.x * 8 + wid; row0 < S_; row0 += 2 * rstride) {
        f32x4g v[2][4]; f32x4g o[2][4]; bool ok[2];
#pragma unroll
        for (int r = 0; r < 2; ++r) { const int row = row0 + r * rstride; ok[r] = row < S_; const int rw = ok[r] ? row : row0;
#pragma unroll
            for (int j = 0; j < 4; ++j) { if constexpr (XIN == 1) { const u32x2g xb = *((const u32x2g*)(XB + (size_t)rw * 1024) + lane + 64 * j);
                    v[r][j] = (f32x4g){__uint_as_float(xb.x << 16), __uint_as_float(xb.x & 0xffff0000u), __uint_as_float(xb.y << 16), __uint_as_float(xb.y & 0xffff0000u)}; }
                else v[r][j] = *((const f32x4g*)(xprev + (size_t)rw * 1024) + lane + 64 * j); }
            if constexpr (HAS_O) {
#pragma unroll
                for (int j = 0; j < 4; ++j) { const u32x2g ob = *((const u32x2g*)(O + (size_t)rw * 1024) + lane + 64 * j);
                    o[r][j] = (f32x4g){__uint_as_float(ob.x << 16), __uint_as_float(ob.x & 0xffff0000u), __uint_as_float(ob.y << 16), __uint_as_float(ob.y & 0xffff0000u)}; } } }
#pragma unroll
        for (int r = 0; r < 2; ++r) { const int row = row0 + r * rstride; if (!ok[r]) continue;
            if constexpr (HAS_O) { float s = 0.f;
#pragma unroll
                for (int j = 0; j < 4; ++j) s += (o[r][j].x * o[r][j].x + o[r][j].y * o[r][j].y) + (o[r][j].z * o[r][j].z + o[r][j].w * o[r][j].w);
                const float rs = 1.0f / sqrtf(wave_sum(s) * (1.f / 1024.f) + EPS_);
#pragma unroll
                for (int j = 0; j < 4; ++j) { v[r][j] = v[r][j] + o[r][j] * rs * gpo[j];
                    if constexpr (XOUT == 1) { u32x2g w; w.x = pk2(v[r][j].x, v[r][j].y); w.y = pk2(v[r][j].z, v[r][j].w); *((u32x2g*)(XB + (size_t)row * 1024) + lane + 64 * j) = w; }
                    else *((f32x4g*)(p.out + (size_t)row * 1024) + lane + 64 * j) = v[r][j]; } }
            if constexpr (HAS_H) {
                float s = 0.f;
#pragma unroll
                for (int j = 0; j < 4; ++j) s += (v[r][j].x * v[r][j].x + v[r][j].y * v[r][j].y) + (v[r][j].z * v[r][j].z + v[r][j].w * v[r][j].w);
                const float rs = 1.0f / sqrtf(wave_sum(s) * (1.f / 1024.f) + EPS_);
#pragma unroll
                for (int j = 0; j < 4; ++j) { v[r][j] = v[r][j] * rs * gpr[j];
                    u32x2g w; w.x = pk2(v[r][j].x, v[r][j].y); w.y = pk2(v[r][j].z, v[r][j].w);
                    *((u32x2g*)(H + (size_t)row * 1024) + lane + 64 * j) = w; }
                if constexpr (FG) {
                float mine = 0.f;
#pragma unroll
                for (int g = 0; g < 8; ++g) { float a = 0.f;
#pragma unroll
                    for (int j = 0; j < 4; ++j) { const f32x4g w = *((const LAS f32x4g*)(wfl + g * 1024) + lane + 64 * j); a += (v[r][j].x * w.x + v[r][j].y * w.y) + (v[r][j].z * w.z + v[r][j].w * w.w); }
                    a = wave_sum(a); if (lane == g) mine = a; }
                if (lane < 8) { const float z = mine + bfv; const float ls = fminf(z, 0.f) - log1pf(expf(-fabsf(z))); LF[(size_t)row * 8 + lane] = ls; }
                }
            }
        }
    }
}

__device__ __forceinline__ void fgate_mfma(const Params& p, int L, LAS unsigned char* lds, int tid) {
    asm volatile("" : "+v"(tid));
    unsigned char* ws = wsbase(p); const int lane = tid & 63, w = tid >> 6, l15 = lane & 15, lq = lane >> 4, rt = w & 3, kh = w >> 2;
    const u16* H = (const u16*)(ws + WS_H); const u16* WFB = (const u16*)(ws + WS_WF) + (size_t)L * 16 * 1024; float* LF = (float*)(ws + WS_LF);
    LAS unsigned char* wst = lds + 8192;
    for (int i = tid; i < 2048; i += NTHR) { const int rw = i >> 7, c16 = i & 127; *(LAS u32x4g*)(wst + rw * 2064 + c16 * 16) = *((const u32x4g*)(WFB + (size_t)rw * 1024) + c16); }
    __syncthreads();
    for (int rg = blockIdx.x; rg < S_ / 64; rg += gridDim.x) {
    const int r0 = rg * 64 + rt * 16;
    const u16* ap = H + (size_t)(r0 + l15) * 1024 + kh * 512 + 8 * lq; const LAS unsigned char* bp = wst + l15 * 2064 + (kh * 512 + 8 * lq) * 2;
    pg8::f32x4 acc = {0.f, 0.f, 0.f, 0.f};
#pragma unroll
    for (int ks = 0; ks < 16; ++ks) { const bf16x8g a = *(const bf16x8g*)(ap + ks * 32), b = *(const LAS bf16x8g*)(bp + ks * 64); acc = __builtin_amdgcn_mfma_f32_16x16x32_bf16(a, b, acc, 0, 0, 0); }
    float v[4];
#pragma unroll
    for (int j = 0; j < 4; ++j) v[j] = acc[j] + __shfl_xor(acc[j], 8);
    LAS float* xch = (LAS float*)lds;
    if (kh == 1) { *(LAS f32x4g*)(xch + (rt * 64 + lane) * 4) = (f32x4g){v[0], v[1], v[2], v[3]}; }
    __syncthreads();
    if (kh == 0) { const f32x4g o = *(const LAS f32x4g*)(xch + (rt * 64 + lane) * 4);
        if (l15 < 8) { const float bfv = p.b_f[L * 8 + l15];
#pragma unroll
            for (int j = 0; j < 4; ++j) { const float z = v[j] + o[j] + bfv; LF[(size_t)(r0 + lq * 4 + j) * 8 + l15] = fminf(z, 0.f) - log1pf(expf(-fabsf(z))); } } }
    __syncthreads();
    }
}

__device__ __forceinline__ void cumsum_item(const Params& p, int j, int tid) {
    asm volatile("" : "+v"(tid));
    unsigned char* ws = wsbase(p); const float* LF = (const float*)(ws + WS_LF); float* CL = (float*)(ws + WS_CL); float* TB = (float*)(ws + WS_TB);
    const int lane = tid & 63, h = tid >> 6; const int r0 = j * 1024 + lane * 16;
    float v[16]; float run = 0.f;
#pragma unroll
    for (int i = 0; i < 16; ++i) { run += LF[(size_t)(r0 + i) * 8 + h]; v[i] = run; }
    float inc = run;
#pragma unroll
    for (int o = 1; o < 64; o <<= 1) { const float t = __shfl_up(inc, o); if (lane >= o) inc += t; }
    const float excl = inc - run;
#pragma unroll
    for (int i = 0; i < 16; ++i) CL[(size_t)h * S_ + r0 + i] = (excl + v[i]) * LOG2E;
    if (lane == 63) TB[h * 16 + j] = inc * LOG2E;
}

__device__ __forceinline__ void qknorm_item(const Params& p, int h, int qb, LAS unsigned char* lds, int tid) {
    asm volatile("" : "+v"(tid));
    unsigned char* ws = wsbase(p); const u16* P = (const u16*)(ws + WS_P); float* QN = (float*)(ws + WS_QN);
    const int row = qb * 256 + (tid >> 1), half = tid & 1;
    const u16* qp = P + (size_t)row * PP + C_FQ + h * 64 + half * 32; const u16* kp = P + (size_t)row * PP + C_FK + h * 64 + half * 32;
    float sq = 0.f, sk = 0.f, sd = 0.f;
#pragma unroll
    for (int i = 0; i < 4; ++i) { const u32x4g a = *(const u32x4g*)(qp + 8 * i), b = *(const u32x4g*)(kp + 8 * i);
#pragma unroll
        for (int e = 0; e < 4; ++e) { const float a0 = __uint_as_float(a[e] << 16), a1 = __uint_as_float(a[e] & 0xffff0000u), b0 = __uint_as_float(b[e] << 16), b1 = __uint_as_float(b[e] & 0xffff0000u);
            sq += a0 * a0 + a1 * a1; sk += b0 * b0 + b1 * b1; sd += a0 * b0 + a1 * b1; } }
    sq += __shfl_xor(sq, 1); sk += __shfl_xor(sk, 1); sd += __shfl_xor(sd, 1);
    if (half == 0) ((float*)(ws + WS_DQ))[(size_t)h * S_ + row] = sd - 1e-3f * (1.f + fabsf(sd));
#pragma unroll
    for (int o = 2; o < 64; o <<= 1) { sq = fmaxf(sq, __shfl_xor(sq, o)); sk = fmaxf(sk, __shfl_xor(sk, o)); sd = fminf(sd, __shfl_xor(sd, o)); }
    LAS float* red = (LAS float*)lds;
    if ((tid & 63) == 0) { red[tid >> 6] = sq; red[8 + (tid >> 6)] = sk; red[16 + (tid >> 6)] = sd; }
    __syncthreads();
    if (tid == 0) { float a = red[0], b = red[8], c = red[16];
#pragma unroll
        for (int w = 1; w < 8; ++w) { a = fmaxf(a, red[w]); b = fmaxf(b, red[8 + w]); c = fminf(c, red[16 + w]); }
        QN[h * 64 + qb] = a * 1.0001f; QN[512 + h * 64 + qb] = b * 1.0001f; QN[1024 + h * 64 + qb] = c; }
    __syncthreads();
}

__device__ __forceinline__ float ret_log2_gamma(int h) { return log2f(1.0f - exp2f(-5.0f - (float)h)); }

__device__ __forceinline__ void ret_state_item(const Params& p, int h, int n, LAS unsigned char* lds, int tid) {
    asm volatile("" : "+v"(tid));
    unsigned char* ws = wsbase(p); const u16* P = (const u16*)(ws + WS_P); float* KV = (float*)(ws + WS_KVST) + ((size_t)(h * 128 + n)) * 4096;
    LAS u16* KT = (LAS u16*)lds; LAS u16* VT = KT + 64 * 136;
    const float lg = ret_log2_gamma(h);
#pragma unroll
    for (int i = 0; i < 2; ++i) { const int pc = tid + 512 * i, tok = pc >> 3, dch = pc & 7;
        const u32x4g kk = *(const u32x4g*)(P + (size_t)(n * 128 + tok) * PP + C_RK + h * 64 + dch * 8);
        const u32x4g vv = *(const u32x4g*)(P + (size_t)(n * 128 + tok) * PP + C_RV + h * 64 + dch * 8);
        const float zeta = exp2f(lg * (float)(127 - tok));
#pragma unroll
        for (int e = 0; e < 4; ++e) { KT[(dch * 8 + 2 * e) * 136 + tok] = (u16)(kk[e] & 0xffffu); KT[(dch * 8 + 2 * e + 1) * 136 + tok] = (u16)(kk[e] >> 16);
            VT[(dch * 8 + 2 * e) * 136 + tok] = (u16)f2bf(__uint_as_float(vv[e] << 16) * zeta); VT[(dch * 8 + 2 * e + 1) * 136 + tok] = (u16)f2bf(__uint_as_float(vv[e] & 0xffff0000u) * zeta); } }
    __syncthreads();
    const int lane = tid & 63, w = tid >> 6, l15 = lane & 15, lq = lane >> 4; const int dt = w >> 1;
#pragma unroll
    for (int ee = 0; ee < 2; ++ee) { const int et = (w & 1) * 2 + ee; pg8::f32x4 acc = {0.f, 0.f, 0.f, 0.f};
#pragma unroll
        for (int ks = 0; ks < 4; ++ks) { const bf16x8g a = *(const LAS bf16x8g*)(KT + (dt * 16 + l15) * 136 + ks * 32 + 8 * lq); const bf16x8g b = *(const LAS bf16x8g*)(VT + (et * 16 + l15) * 136 + ks * 32 + 8 * lq);
            acc = __builtin_amdgcn_mfma_f32_16x16x32_bf16(a, b, acc, 0, 0, 0); }
#pragma unroll
        for (int j = 0; j < 4; ++j) KV[(dt * 16 + lq * 4 + j) * 64 + et * 16 + l15] = acc[j]; }
    __syncthreads();
}

constexpr int RGC = 8;
__device__ __forceinline__ void ret_out_group(const Params& p, int h, int n0, LAS unsigned char* lds, int tid) {
    asm volatile("" : "+v"(tid));
    unsigned char* ws = wsbase(p); const u16* P = (const u16*)(ws + WS_P); const float* KV = (const float*)(ws + WS_KVST) + (size_t)h * 128 * 4096; u16* Y = (u16*)(ws + WS_H);
    LAS u16* Qs = (LAS u16*)lds; LAS u16* Ks = Qs + 128 * 72; LAS u16* VT = Ks + 128 * 72; LAS u16* Ss = VT + 64 * 136; LAS u16* RT = Ss + 128 * 136;
    const float lg = ret_log2_gamma(h); const float g = exp2f(lg * 128.f);
    const int lane = tid & 63, w = tid >> 6, l15 = lane & 15, lq = lane >> 4;
    f32x4g r0 = {0.f, 0.f, 0.f, 0.f}, r1 = {0.f, 0.f, 0.f, 0.f}; const float* src = KV + tid * 8;
    { f32x4g s0 = {0.f, 0.f, 0.f, 0.f}, s1 = {0.f, 0.f, 0.f, 0.f};
      const float g2 = g * g; int j = 0;
#pragma unroll 4
      for (; j + 1 < n0; j += 2) { const f32x4g a = *(const f32x4g*)(src + (size_t)j * 4096), b = *(const f32x4g*)(src + (size_t)j * 4096 + 4), c = *(const f32x4g*)(src + (size_t)(j + 1) * 4096), d = *(const f32x4g*)(src + (size_t)(j + 1) * 4096 + 4);
          r0 = r0 * g2 + a; r1 = r1 * g2 + b; s0 = s0 * g2 + c; s1 = s1 * g2 + d; }
      r0 = r0 * g + s0; r1 = r1 * g + s1; }
    u32x4g pq[2], pk[2], pv[2]; f32x4g ka = {0.f, 0.f, 0.f, 0.f}, kb = {0.f, 0.f, 0.f, 0.f};
#define RET_LOAD(nn) do { _Pragma("unroll") for (int i = 0; i < 2; ++i) { const int pc = tid + 512 * i, tok = pc >> 3, dch = pc & 7; const size_t rb = (size_t)((nn) * 128 + tok) * PP + h * 64 + dch * 8; \
        pq[i] = *(const u32x4g*)(P + rb + C_RQ); pk[i] = *(const u32x4g*)(P + rb + C_RK); pv[i] = *(const u32x4g*)(P + rb + C_RV); } } while (0)
    RET_LOAD(n0);
    for (int c8 = 0; c8 < RGC; ++c8) { const int n = n0 + c8;
        if (c8 > 0) { r0 = r0 * g + ka; r1 = r1 * g + kb; }
#pragma unroll
        for (int i = 0; i < 2; ++i) { const int pc = tid + 512 * i, tok = pc >> 3, dch = pc & 7;
            *(LAS u32x4g*)(Qs + tok * 72 + dch * 8) = pq[i];
            *(LAS u32x4g*)(Ks + tok * 72 + dch * 8) = pk[i];
            const u32x4g vv = pv[i];
#pragma unroll
            for (int e = 0; e < 4; ++e) { VT[(dch * 8 + 2 * e) * 136 + tok] = (u16)(vv[e] & 0xffffu); VT[(dch * 8 + 2 * e + 1) * 136 + tok] = (u16)(vv[e] >> 16); } }
        { const int d = tid >> 3, e0 = (tid & 7) * 8;
#pragma unroll
          for (int e = 0; e < 4; ++e) { RT[(e0 + e) * 72 + d] = (u16)f2bf(r0[e]); RT[(e0 + 4 + e) * 72 + d] = (u16)f2bf(r1[e]); } }
        __syncthreads();
        if (c8 + 1 < RGC) { RET_LOAD(n + 1); ka = *(const f32x4g*)(src + (size_t)n * 4096); kb = *(const f32x4g*)(src + (size_t)n * 4096 + 4); }
        u16 zg[4][4];
#pragma unroll
        for (int j = 0; j < 4; ++j)
#pragma unroll
            for (int et = 0; et < 4; ++et) zg[j][et] = P[(size_t)(n * 128 + w * 16 + lq * 4 + j) * PP + C_RZ + h * 64 + et * 16 + l15];
        bf16x8g qa[2];
#pragma unroll
        for (int ks = 0; ks < 2; ++ks) qa[ks] = *(const LAS bf16x8g*)(Qs + (w * 16 + l15) * 72 + ks * 32 + 8 * lq);
#pragma unroll
        for (int mt = 0; mt < 8; ++mt) { pg8::f32x4 acc = {0.f, 0.f, 0.f, 0.f};
            if (mt <= w) {
#pragma unroll
                for (int ks = 0; ks < 2; ++ks) { const bf16x8g b = *(const LAS bf16x8g*)(Ks + (mt * 16 + l15) * 72 + ks * 32 + 8 * lq); acc = __builtin_amdgcn_mfma_f32_16x16x32_bf16(qa[ks], b, acc, 0, 0, 0); } }
#pragma unroll
            for (int j = 0; j < 4; ++j) { const int c = w * 16 + lq * 4 + j, m = mt * 16 + l15; const float dv = (c >= m) ? acc[j] * exp2f(lg * (float)(c - m)) : 0.f; Ss[c * 136 + m] = (u16)f2bf(dv); } }
        __syncthreads();
        pg8::f32x4 o1[4], o2[4];
#pragma unroll
        for (int et = 0; et < 4; ++et) { o1[et] = (pg8::f32x4){0.f, 0.f, 0.f, 0.f}; o2[et] = (pg8::f32x4){0.f, 0.f, 0.f, 0.f}; }
        const int ksmax = w >> 1;
        for (int ks = 0; ks <= ksmax; ++ks) { const bf16x8g a = *(const LAS bf16x8g*)(Ss + (w * 16 + l15) * 136 + ks * 32 + 8 * lq);
#pragma unroll
            for (int et = 0; et < 4; ++et) { const bf16x8g b = *(const LAS bf16x8g*)(VT + (et * 16 + l15) * 136 + ks * 32 + 8 * lq); o1[et] = __builtin_amdgcn_mfma_f32_16x16x32_bf16(a, b, o1[et], 0, 0, 0); } }
#pragma unroll
        for (int ks = 0; ks < 2; ++ks)
#pragma unroll
            for (int et = 0; et < 4; ++et) { const bf16x8g b = *(const LAS bf16x8g*)(RT + (et * 16 + l15) * 72 + ks * 32 + 8 * lq); o2[et] = __builtin_amdgcn_mfma_f32_16x16x32_bf16(qa[ks], b, o2[et], 0, 0, 0); }
#pragma unroll
        for (int j = 0; j < 4; ++j) { const int c = w * 16 + lq * 4 + j; const float xi = exp2f(lg * (float)(c + 1)); float ov[4]; float ss = 0.f;
#pragma unroll
            for (int et = 0; et < 4; ++et) { ov[et] = o1[et][j] + xi * o2[et][j]; ss += ov[et] * ov[et]; }
            ss += __shfl_xor(ss, 1); ss += __shfl_xor(ss, 2); ss += __shfl_xor(ss, 4); ss += __shfl_xor(ss, 8);
            const float rs = 1.0f / sqrtf(ss * (1.f / 64.f) + EPS_); const size_t row = (size_t)(n * 128 + c);
#pragma unroll
            for (int et = 0; et < 4; ++et) { const float z = bf2f(zg[j][et]); Y[row * 1024 + 512 + h * 64 + et * 16 + l15] = (u16)f2bf(ov[et] * rs * (z / (1.f + __expf(-z)))); } }
        __syncthreads();
    }
#undef RET_LOAD
}

struct EpiIn {
    static constexpr bool PERM = true, AFTER_DRAIN = false;
    u16* P; u16* MKV; const float* rope;
    __device__ __forceinline__ void operator()(const pg8::f32x4 (&acc)[2][2][4][2], const pg8::Unit& u, int wr, int wc, int fr, int fq) const {
        u16* base; int pitch, row0, colt; float sc = 1.f; bool rot = false;
        if (u.pm >= 64) { const int l = u.pm - 64; base = MKV + (size_t)l * 256 * 512; pitch = 512; row0 = 0; colt = (u.pn - 14 - 2 * l) * 256; }
        else { base = P; pitch = PP; row0 = u.pm * 256; colt = u.pn * 256;
            if (u.pn < 2 || u.pn == 12) sc = fa::C2; else if (u.pn == 8) rot = true; else if (u.pn == 9) { rot = true; sc = 0.125f; } }
#pragma unroll
        for (int ai = 0; ai < 2; ++ai)
#pragma unroll
            for (int m = 0; m < 4; ++m) { const int rr = ai * 128 + wr * 64 + m * 16 + fr; const int row = row0 + rr;
#pragma unroll
                for (int bj = 0; bj < 2; ++bj) { const int cl = bj * 128 + wc * 32 + 8 * fq; pg8::f32x4 v0 = acc[ai][bj][m][0], v1 = acc[ai][bj][m][1];
                    if (rot) { const f32x4g* rp = (const f32x4g*)(rope + ((size_t)row * 32 + ((cl & 63) >> 1)) * 2); const f32x4g c0 = rp[0], c1 = rp[1];
                        float a, b; a = v0[0] * c0[0] - v0[1] * c0[1]; b = v0[0] * c0[1] + v0[1] * c0[0]; v0[0] = a; v0[1] = b;
                        a = v0[2] * c0[2] - v0[3] * c0[3]; b = v0[2] * c0[3] + v0[3] * c0[2]; v0[2] = a; v0[3] = b;
                        a = v1[0] * c1[0] - v1[1] * c1[1]; b = v1[0] * c1[1] + v1[1] * c1[0]; v1[0] = a; v1[1] = b;
                        a = v1[2] * c1[2] - v1[3] * c1[3]; b = v1[2] * c1[3] + v1[3] * c1[2]; v1[2] = a; v1[3] = b; }
                    u32x4g w; w.x = pk2(v0[0] * sc, v0[1] * sc); w.y = pk2(v0[2] * sc, v0[3] * sc); w.z = pk2(v1[0] * sc, v1[1] * sc); w.w = pk2(v1[2] * sc, v1[3] * sc);
                    st16_wt(base + (size_t)row * pitch + colt + cl, w); } }
    }
};
struct EpiOut {
    static constexpr bool PERM = true, AFTER_DRAIN = false;
    u16* O;
    __device__ __forceinline__ void operator()(const pg8::f32x4 (&acc)[2][2][4][2], const pg8::Unit& u, int wr, int wc, int fr, int fq) const {
#pragma unroll
        for (int ai = 0; ai < 2; ++ai)
#pragma unroll
            for (int m = 0; m < 4; ++m) { const int row = u.pm * 256 + ai * 128 + wr * 64 + m * 16 + fr;
#pragma unroll
                for (int bj = 0; bj < 2; ++bj) { const int col = u.pn * 256 + bj * 128 + wc * 32 + 8 * fq; const pg8::f32x4 v0 = acc[ai][bj][m][0], v1 = acc[ai][bj][m][1];
                    u32x4g w; w.x = pk2(v0[0], v0[1]); w.y = pk2(v0[2], v0[3]); w.z = pk2(v1[0], v1[1]); w.w = pk2(v1[2], v1[3]);
                    st16_wt(O + (size_t)row * 1024 + col, w); } }
    }
};
struct OrderList {
    int first, G, count;
    __device__ __forceinline__ bool next(int i, pg8::Unit& u) const { const int L = first + i * G; if (L >= count) return false;
        if (L < 128) { u.pm = L >> 1; u.pn = 12 + (L & 1); } else { const int q = L - 128; u.pm = 64 + (q >> 1); u.pn = 14 + q; } return true; }
    __device__ __forceinline__ void a_ready(const pg8::Unit&) const {}
    __device__ __forceinline__ void done(const pg8::Unit&) const {}
};

#define XB_TMO      128
#define XB_XCNT(j)  (256  + 64 * (j))
#define XB_XSUB(j)  (1280 + 64 * (j))
#define XB_XGEN(j)  (2304 + 64 * (j))
#define XB_TOP      3328
#define XB_TOPGEN   3392
#define XCD_BAR_WORDS 3456
#define XB_SPIN_CAP (1u << 18)

__device__ __forceinline__ unsigned xb_ld(unsigned* p)              { return __hip_atomic_load(p, __ATOMIC_RELAXED, __HIP_MEMORY_SCOPE_AGENT); }
__device__ __forceinline__ unsigned xb_add(unsigned* p, unsigned v) { return __hip_atomic_fetch_add(p, v, __ATOMIC_RELAXED, __HIP_MEMORY_SCOPE_AGENT); }
__device__ __forceinline__ unsigned xb_xcc_id() { return (unsigned)__builtin_amdgcn_s_getreg((3 << 11) | 20) & 0xFu; }
#define XB_SPIN(cond, bar) do { unsigned _sp = 0; while (cond) { __builtin_amdgcn_s_sleep(1); \
    if ((++_sp & 255u) == 0u) { if (xb_ld(&(bar)[XB_TMO])) break; if (_sp > XB_SPIN_CAP) { atomicAdd(&(bar)[XB_TMO], 1u); break; } } } } while (0)

struct XcdBarrier {
    unsigned* bar; unsigned x;
    volatile LAS unsigned* st;
};

__device__ __forceinline__ XcdBarrier xcd_barrier_post(unsigned* bar, volatile LAS unsigned* st) {
    XcdBarrier b; b.bar = bar; b.x = xb_xcc_id(); b.st = st;
    if (threadIdx.x == 0) (void)xb_add(&bar[XB_XCNT(b.x)], 1u);
    return b;
}
__device__ __forceinline__ void xcd_barrier_complete(unsigned* bar, unsigned x, unsigned& nloc, unsigned& nx) {
    const unsigned G = gridDim.x * gridDim.y * gridDim.z;
    unsigned sum, cnt, mine, sp = 0u;
    for (;;) {
        sum = 0u; cnt = 0u; mine = 0u;
#pragma unroll
        for (unsigned j = 0; j < 16; ++j) { const unsigned c = xb_ld(&bar[XB_XCNT(j)]); sum += c; cnt += (c > 0u) ? 1u : 0u; mine = (j == x) ? c : mine; }
        if (sum == G) break;
        __builtin_amdgcn_s_sleep(1);
        if ((++sp & 255u) == 0u) { if (xb_ld(&bar[XB_TMO])) break; if (sp > XB_SPIN_CAP) { atomicAdd(&bar[XB_TMO], 1u); break; } }
    }
    nloc = mine > 0u ? mine : 1u; nx = cnt > 0u ? cnt : 1u;
}

__device__ __forceinline__ void xcd_barrier(const XcdBarrier& b) {
    asm volatile("s_waitcnt vmcnt(0)" ::: "memory");
    __syncthreads();
    if (threadIdx.x == 0) {
        unsigned* bar = b.bar;
        __builtin_amdgcn_s_waitcnt(0);
        unsigned nloc = b.st[0], nx = b.st[1];
        if (nloc == 0u) { xcd_barrier_complete(bar, b.x, nloc, nx); b.st[0] = nloc; b.st[1] = nx; }
        const unsigned old = xb_add(&bar[XB_XSUB(b.x)], 1u);
        const unsigned gen = old / nloc;
        if (old + 1u == (gen + 1u) * nloc) {
            __builtin_amdgcn_fence(__ATOMIC_RELEASE, "agent");
            asm volatile("s_waitcnt vmcnt(0)" ::: "memory");
            const unsigned og = xb_add(&bar[XB_TOP], 1u);
            const unsigned tg = og / nx;
            if (og + 1u == (tg + 1u) * nx) xb_add(&bar[XB_TOPGEN], 1u);
            else XB_SPIN(xb_ld(&bar[XB_TOPGEN]) == tg, bar);
            __builtin_amdgcn_fence(__ATOMIC_ACQUIRE, "agent");
            xb_add(&bar[XB_XGEN(b.x)], 1u);
            asm volatile("s_waitcnt vmcnt(0)" ::: "memory");
        } else {
            XB_SPIN(xb_ld(&bar[XB_XGEN(b.x)]) == gen, bar);
            __builtin_amdgcn_fence(__ATOMIC_ACQUIRE, "agent");
            asm volatile("s_waitcnt vmcnt(0)" ::: "memory");
        }
    }
    __syncthreads();
}


constexpr int N_PHASES = 1 + 5 * DEPTH_;
template <bool COOP>
__global__ void __launch_bounds__(NTHR, 2) mk_fwd(Params p) {
    extern __shared__ __attribute__((aligned(16))) unsigned char lds_raw[];
    LAS unsigned char* lds = (LAS unsigned char*)lds_raw;
    const int tid = threadIdx.x, G = gridDim.x, bx = blockIdx.x;
    unsigned char* ws = p.ws;
    const int lo = p.ph_lo, hi = p.ph_hi;
#define IN(k) (lo <= (k) && (k) < hi)
#define SEAM(k) do { if (IN(k) && IN((k) + 1)) { if constexpr (COOP) { xcd_barrier(bar); } } } while (0)
    volatile LAS unsigned* bst = (volatile LAS unsigned*)(lds + LDS_BYTES - 64);
    if (tid == 0) { bst[0] = 0u; bst[1] = 0u; }
    __syncthreads();
    XcdBarrier bar; bar.bar = (unsigned*)ws; bar.x = 0; bar.st = bst;
    if constexpr (COOP) { bar = xcd_barrier_post((unsigned*)ws, bst); if (lo < 0) cg::this_grid().sync(); }

#ifndef SKIP_P0
    if (IN(0)) {
        LAS float* scr = (LAS float*)lds;
        transpose_range(p, 0, 4 * (896 + 256 + 128), bx, G, scr, tid);
        for (int i = bx * NTHR + tid; i < 4 * 8 * 1024; i += G * NTHR) { const int l = i >> 13, c = (i >> 10) & 7, k = i & 1023; const float wv = p.w_in[(size_t)l * 1024 * DIN_ORIG + (size_t)k * DIN_ORIG + 2048 + c];
            const unsigned hb = f2bf(wv); const float hf = __uint_as_float(hb << 16); u16* wfb = (u16*)(ws + WS_WF) + (size_t)l * 16 * 1024;
            wfb[(size_t)c * 1024 + k] = (u16)hb; wfb[(size_t)(8 + c) * 1024 + k] = (u16)f2bf(wv - hf); }
        for (int i = bx * NTHR + tid; i < S_ * 32; i += G * NTHR) { const int pos = i >> 5, fi = i & 31;
            const float freq = (float)exp2(-(double)fi * (13.287712379549449 / 32.0)); const float ang = (float)pos * freq;
            const double rev = (double)ang * 0.15915494309189535; const float fr = (float)(rev - rint(rev));
            float* o = (float*)(ws + WS_ROPE) + (size_t)i * 2; o[0] = __builtin_amdgcn_cosf(fr); o[1] = __builtin_amdgcn_sinf(fr); }
        { const int lane = tid & 63, wid = tid >> 6;
          for (int rw = bx * 8 + wid; rw < 4 * NMEM; rw += G * 8) { const int l = rw >> 8, m = rw & 255; f32x4g v[4]; float s = 0.f;
#pragma unroll
              for (int j = 0; j < 4; ++j) { v[j] = *((const f32x4g*)(p.mem + (size_t)m * 1024) + lane + 64 * j); s += (v[j].x * v[j].x + v[j].y * v[j].y) + (v[j].z * v[j].z + v[j].w * v[j].w); }
              const float rs = 1.0f / sqrtf(wave_sum(s) * (1.f / 1024.f) + EPS_);
#pragma unroll
              for (int j = 0; j < 4; ++j) { const f32x4g g = *((const f32x4g*)(p.g_mem + (size_t)l * 1024) + lane + 64 * j); v[j] = v[j] * rs * g;
                  u32x2g w; w.x = pk2(v[j].x, v[j].y); w.y = pk2(v[j].z, v[j].w); *((u32x2g*)((u16*)(ws + WS_H) + (size_t)(S_ + rw) * 1024) + lane + 64 * j) = w; } } }
        __syncthreads();
        norm_phase<0, 0, true>(p, 0, (LAS float*)lds, tid);
        __syncthreads();
    }
#endif
    SEAM(0);

    for (int l = 0; l < DEPTH_; ++l) {
        const int pb = 1 + 5 * l;
#ifndef SKIP_INPROJ
        if (IN(pb)) {
            unsigned char* ws = wsbase(p);
            const u16* Bt = (const u16*)(ws + (l == 0 ? WS_BT0 : WS_BT1 + (size_t)(l - 1) * BT_STRIDE));
            pg8::Gemm g{(const u16*)(ws + WS_H), Bt, S_, NIN, 1024};
            EpiIn E{(u16*)(ws + WS_P), (u16*)(ws + WS_MKV), (const float*)(ws + WS_ROPE)};
            if (l > 0) fgate_mfma(p, l, lds, tid);
            { pg8::StaticOrder S; S.init(S_, 3072, G, bx); pg8::gemm_phase<EpiIn, pg8::StaticOrder, true, true>(lds, g, S, E); }
            __syncthreads();
        }
#endif
        SEAM(pb);
#ifndef SKIP_MID
        if (IN(pb + 1)) {
            unsigned char* ws = wsbase(p);
            const int NU = 128 + (l == 0 ? 8 : 0);
            const bool sep = G >= NU + 64; const int w0 = sep ? NU : 0, nw = sep ? G - NU : G;
            if (bx < NU || !sep) {
                const u16* Bt = (const u16*)(ws + (l == 0 ? WS_BT0 : WS_BT1 + (size_t)(l - 1) * BT_STRIDE));
                pg8::Gemm g{(const u16*)(ws + WS_H), Bt, S_, NIN, 1024};
                EpiIn E{(u16*)(ws + WS_P), (u16*)(ws + WS_MKV), (const float*)(ws + WS_ROPE)};
                OrderList S{bx, G, NU}; pg8::gemm_phase<EpiIn, OrderList, false, true>(lds, g, S, E);
                __syncthreads();
            }
            if (bx >= w0) {
                for (int it = bx - w0; it < 16 + 512 + 512; it += nw) {
                    if (it < 16) cumsum_item(p, it, tid);
                    else if (it < 528) { const int q = it - 16; ret_state_item(p, q >> 7, q & 127, lds, tid); }
                    else { const int q = it - 528; qknorm_item(p, q >> 6, q & 63, lds, tid); }
                }
            }
            __syncthreads();
        }
#endif
        SEAM(pb + 1);
#ifndef SKIP_MIX
        if (IN(pb + 2)) {
            unsigned char* ws = wsbase(p);
            const fa::bf16* P = (const fa::bf16*)(ws + WS_P); fa::bf16* Y = (fa::bf16*)(ws + WS_H);
            const fa::bf16* MKV = (const fa::bf16*)(ws + WS_MKV) + (size_t)l * 256 * 512;
            char* shm = (char*)lds_raw;
            unsigned* qctr = (unsigned*)ws + 3584 + 64 * l; unsigned* flags = (unsigned*)ws + 4096 + 1024 * l;
            volatile LAS int* qitem = (volatile LAS int*)(lds + LDS_BYTES - 64) + 4;
            const float* QN = (const float*)(ws + WS_QN);
            constexpr int NRET = 512 / RGC, NFAR = FOX_SPLIT ? 768 : 0, I1 = NRET, I2 = I1 + NFAR, I3 = I2 + 512, I4 = I3 + 256;
            for (;;) {
                if (tid == 0) qitem[0] = (int)__hip_atomic_fetch_add(qctr, 1u, __ATOMIC_RELAXED, __HIP_MEMORY_SCOPE_AGENT);
                __syncthreads();
                const int it = __builtin_amdgcn_readfirstlane(qitem[0]);
                __syncthreads();
                if (it >= I4) break;
                if (it < I1) { ret_out_group(p, it & 3, (128 / RGC - 1 - (it >> 2)) * RGC, lds, tid); }
                else if (it < I3) {
                    int h, qb, part = 0;
                    if (it < I2) { const int q = it - I1; h = 7 - q / 96; const int r = q % 96; if (r < 48) { part = 1; qb = 63 - r; } else if (r < 80) { part = 2; qb = 111 - r; } else { part = 3; qb = 143 - r; } }
                    else { const int q = it - I2; h = 7 - (q >> 6); qb = 63 - (q & 63); }
                    const int q0 = qb * 256; unsigned* fl = FOX_SPLIT ? flags + (7 - h) * 96 : nullptr; unsigned char* sl = ws + WS_PART + (size_t)(7 - h) * 96 * fa::SLOT_BYTES;
                    const float* Cl = (const float*)(ws + WS_CL) + (size_t)h * S_; const float* Tb = (const float*)(ws + WS_TB) + h * 16;
                    if (FOX_SPLIT && part) fa::attn_unit<8, false, true, PP, PP, 1024, 1>(q0, 0, (q0 + 256) / 64, P + C_FQ + h * 64, P + C_FK + h * 64, P + C_FV + h * 64, P + C_FZ + h * 64, Y + h * 64, Cl, Tb, QN + h * 64, QN + 512 + h * 64, (const float*)(ws + WS_DQ) + (size_t)h * S_, PRUNE_THRESH, part, fl, sl, shm);
                    else fa::attn_unit<8, true, true, PP, PP, 1024, 0>(q0, 0, (q0 + 256) / 64, P + C_FQ + h * 64, P + C_FK + h * 64, P + C_FV + h * 64, P + C_FZ + h * 64, Y + h * 64, Cl, Tb, QN + h * 64, QN + 512 + h * 64, (const float*)(ws + WS_DQ) + (size_t)h * S_, PRUNE_THRESH, 0, fl, sl, shm); }
                else { const int q = it - I3, mh = q >> 6, mb = q & 63;
                    fa::attn_unit<8, false, false, PP, 512, 1024, 0>(mb * 256, 0, 4, P + C_MQ + mh * 64, MKV + mh * 64, MKV + 256 + mh * 64, P + C_MZ + mh * 64, Y + 768 + mh * 64, nullptr, nullptr, nullptr, nullptr, nullptr, 0.f, 0, nullptr, nullptr, shm); }
            }
            __syncthreads();
        }
#endif
        SEAM(pb + 2);
#ifndef SKIP_OUTPROJ
        if (IN(pb + 3)) {
            unsigned char* ws = wsbase(p);
            pg8::Gemm g{(const u16*)(ws + WS_H), (const u16*)(ws + WS_WOT) + (size_t)l * 1024 * 1024, S_, 1024, 1024};
            EpiOut E{(u16*)(ws + WS_P)};
            pg8::StaticOrder S; S.init(S_, 1024, G, bx); pg8::gemm_phase<EpiOut, pg8::StaticOrder, false, true>(lds, g, S, E);
            __syncthreads();
        }
#endif
        SEAM(pb + 3);
#ifndef SKIP_NORM
        if (IN(pb + 4)) { if (l == 0) norm_phase<0, 1, false>(p, 1, (LAS float*)lds, tid); else if (l + 1 < DEPTH_) norm_phase<1, 1, false>(p, l + 1, (LAS float*)lds, tid); else norm_phase<1, 2, false>(p, DEPTH_, (LAS float*)lds, tid); __syncthreads(); }
#endif
        SEAM(pb + 4);
    }
#undef IN
#undef SEAM
}

#ifndef MK_MULTI
#define MK_MULTI 0
#endif
extern "C" void kernel_launch(void* const* d_in, const int* in_sizes, int n_in, void* d_out, int out_size, void* d_ws, size_t ws_size, hipStream_t stream) {
    static int grid = 0;
    if (grid == 0) {
        int dev = 0, cus = 0, per_cu = 0;
        hipGetDevice(&dev); hipDeviceGetAttribute(&cus, hipDeviceAttributeMultiprocessorCount, dev);
        hipFuncSetAttribute((const void*)mk_fwd<true>, hipFuncAttributeMaxDynamicSharedMemorySize, LDS_BYTES);
        hipFuncSetAttribute((const void*)mk_fwd<false>, hipFuncAttributeMaxDynamicSharedMemorySize, LDS_BYTES);
        hipOccupancyMaxActiveBlocksPerMultiprocessor(&per_cu, (const void*)mk_fwd<true>, NTHR, LDS_BYTES);
        if (per_cu < 1) { fprintf(stderr, "kernel_launch: occupancy query says %d blocks per CU\n", per_cu); per_cu = 1; }
        if (per_cu > 1) per_cu = 1;
        grid = cus * per_cu; if (grid <= 0) grid = 256;
        (void)hipGetLastError();
    }
    Params p{};
    p.x = (const float*)d_in[0]; p.mem = (const float*)d_in[1]; p.w_in = (const float*)d_in[2]; p.b_f = (const float*)d_in[3]; p.w_out = (const float*)d_in[4];
    p.w_mkv = (const float*)d_in[5]; p.g_pre = (const float*)d_in[6]; p.g_post = (const float*)d_in[7]; p.g_mem = (const float*)d_in[8];
    p.out = (float*)d_out; p.ws = (unsigned char*)d_ws;
#if MK_MULTI
    for (int ph = 0; ph < N_PHASES; ++ph) { p.ph_lo = ph; p.ph_hi = ph + 1; hipLaunchKernelGGL(mk_fwd<false>, dim3(grid), dim3(NTHR), LDS_BYTES, stream, p); }
#else
    p.ph_lo = 0; p.ph_hi = N_PHASES;
    (void)hipMemsetAsync(d_ws, 0, 32768, stream);
    void* args[] = {&p};
    hipError_t e = hipLaunchCooperativeKernel((const void*)mk_fwd<true>, dim3(grid), dim3(NTHR), args, LDS_BYTES, stream);
    if (e != hipSuccess) fprintf(stderr, "cooperative launch failed: %s (grid %d)\n", hipGetErrorString(e), grid);
#endif
}
```
